# Optimizing an MI355X kernel written in HIP

```python
import math
import jax, jax.numpy as jnp
from jax import lax
import numpy as np

D_MODEL = 2048
BATCH = 32
SEQ = 256
DEPTH = 2
DEC_BATCH = 2
DEC_SEQ = 2048
PAST_LEN = 512

GRID_W = 64
N_HEADS = D_MODEL // 256
HEAD_DIM = 128
ATT_W = N_HEADS * HEAD_DIM
MAX_KH = 8
KW = 16
QB = 16
KSPAN = QB + KW
N_QBLK = GRID_W // QB
Q_BLOCK = 128
FNET_GROUPS = 4
FNET_GDIM = D_MODEL // 16
FNET_W = FNET_GROUPS * FNET_GDIM
HY_W = D_MODEL // 4
HYENA_ORDER = 2
FILTER_EMB = 33
FILTER_FF = 64
MIN_DECAY = math.log(1e-2) / 1.5
MAX_DECAY = math.log(1e-2) / 0.3
W_MIX = ATT_W + FNET_W + HY_W
OFF_Q = 0
OFF_K = OFF_Q + ATT_W
OFF_V = OFF_K + ATT_W
OFF_GA = OFF_V + ATT_W
OFF_UB = OFF_GA + ATT_W
OFF_GB = OFF_UB + FNET_W
OFF_HC = OFF_GB + FNET_W
OFF_GC = OFF_HC + 3 * HY_W
OFF_MG = OFF_GC + HY_W
N_IN = OFF_MG + 3 * D_MODEL
EPS = 1e-6
NEG = -1e30

kernel_name = 'hybrid_natten_fnet_hyena_dit_step'


def _rmsnorm(x, g):
    xf = x.astype(jnp.float32)
    y = xf * lax.rsqrt(jnp.mean(xf * xf, axis=-1, keepdims=True) + EPS)
    return (y * g.astype(jnp.float32)).astype(x.dtype)


def _modulated_proj(x, cvec, norm_g, w_ada, b_ada, w_in):
    ada = jax.nn.silu(cvec) @ w_ada + b_ada
    shift, scale, gate = jnp.split(ada, 3, axis=-1)
    h = _rmsnorm(x, norm_g) * (1.0 + scale[:, None, :]) + shift[:, None, :]
    return h @ w_in, gate


def _qkv(proj, q_g, k_g):
    B, L, _ = proj.shape
    q = proj[..., OFF_Q:OFF_K].reshape(B, L, N_HEADS, HEAD_DIM)
    k = proj[..., OFF_K:OFF_V].reshape(B, L, N_HEADS, HEAD_DIM)
    v = proj[..., OFF_V:OFF_GA].reshape(B, L, N_HEADS, HEAD_DIM)
    return _rmsnorm(q, q_g), _rmsnorm(k, k_g), v


def _context_attention(q, k, v):
    B, L, H, Dh = q.shape
    scale = Dh ** -0.5
    qb = q.reshape(B, L // Q_BLOCK, Q_BLOCK, H, Dh).swapaxes(0, 1)

    def blk(qi):
        s = jnp.einsum('bqhd,bkhd->bhqk', qi, k).astype(jnp.float32) * scale
        p = jax.nn.softmax(s, axis=-1).astype(v.dtype)
        return jnp.einsum('bhqk,bkhd->bqhd', p, v)

    o = lax.map(blk, qb)
    return o.swapaxes(0, 1).reshape(B, L, H, Dh)


def _latent_attention(q, k, v, k_ctx, v_ctx, rpb):
    B, L, H, Dh = q.shape
    rows = L // GRID_W
    kh = min(MAX_KH, rows)
    scale = Dh ** -0.5
    qg = q.reshape(B, rows, GRID_W, H, Dh)
    kg = k.reshape(B, rows, GRID_W, H, Dh)
    vg = v.reshape(B, rows, GRID_W, H, Dh)
    cols = np.arange(GRID_W)
    col_start = np.clip(cols - KW // 2, 0, GRID_W - KW)
    blks = np.arange(N_QBLK)
    span_start = np.clip(blks * QB - KW // 2, 0, GRID_W - KSPAN)
    span_cols = span_start[:, None] + np.arange(KSPAN)[None, :]
    q_cols = blks[:, None] * QB + np.arange(QB)[None, :]
    q_cs = col_start[q_cols]
    kc = span_cols[:, None, :]
    col_valid = (kc >= q_cs[..., None]) & (kc < q_cs[..., None] + KW)
    dc_idx = np.clip(kc - q_cols[..., None] + KW - 1, 0, 2 * KW - 2)
    col_bias = rpb[:, :, dc_idx]
    valid = col_valid[:, :, None, :]
    n_win = kh * KSPAN

    def row(r):
        rs = jnp.clip(r - kh // 2, 0, rows - kh)
        q_r = lax.dynamic_index_in_dim(qg, r, axis=1, keepdims=False)
        q_r = q_r.reshape(B, N_QBLK, QB, H, Dh)
        k_blk = lax.dynamic_slice_in_dim(kg, rs, kh, axis=1)[:, :, span_cols]
        v_blk = lax.dynamic_slice_in_dim(vg, rs, kh, axis=1)[:, :, span_cols]
        dr_idx = rs + jnp.arange(kh) - r + (MAX_KH - 1)
        bias = jnp.take(col_bias, dr_idx, axis=1).transpose(0, 2, 3, 1, 4)
        s_win = (jnp.einsum('bnqhd,binkhd->bhnqik', q_r, k_blk).astype(jnp.float32) * scale
                 + bias.astype(jnp.float32))
        s_win = jnp.where(valid, s_win, NEG)
        s_ctx = jnp.einsum('bnqhd,bchd->bhnqc', q_r, k_ctx).astype(jnp.float32) * scale
        s = jnp.concatenate([s_win.reshape(B, H, N_QBLK, QB, n_win), s_ctx], axis=-1)
        p = jax.nn.softmax(s, axis=-1).astype(v.dtype)
        p_win = p[..., :n_win].reshape(B, H, N_QBLK, QB, kh, KSPAN)
        p_ctx = p[..., n_win:]
        o = (jnp.einsum('bhnqik,binkhd->bnqhd', p_win, v_blk)
             + jnp.einsum('bhnqc,bchd->bnqhd', p_ctx, v_ctx))
        return o.reshape(B, GRID_W, H, Dh)

    o = lax.map(row, jnp.arange(rows))
    return o.swapaxes(0, 1).reshape(B, L, H, Dh)


def _fourier_mix(u):
    B, L, _ = u.shape
    uf = u.astype(jnp.float32).reshape(B, L, FNET_GROUPS, FNET_GDIM)
    y = jnp.fft.fft2(uf, axes=(1, 3), norm='ortho').real
    return y.reshape(B, L, FNET_W).astype(u.dtype)


def _short_conv(x, w, b):
    L = x.shape[1]
    xp = jnp.pad(x, ((0, 0), (1, 1), (0, 0)))
    return xp[:, 0:L] * w[0] + xp[:, 1:L + 1] * w[1] + xp[:, 2:L + 2] * w[2] + b


def _hyena_filter_fft(L, f_w1, f_b1, f_freq, f_w2, f_b2, f_w3):
    t = jnp.linspace(0.0, 1.0, L, dtype=jnp.float32)[:, None]
    bands = (FILTER_EMB - 1) // 2
    w = (2.0 * math.pi / L) * jnp.arange(L, dtype=jnp.float32)[:, None]
    f = jnp.linspace(1e-4, bands - 1, bands, dtype=jnp.float32)[None, :]
    z = jnp.concatenate([t, jnp.cos(w * f), -jnp.sin(w * f)], axis=-1)
    h = jnp.sin(f_freq * (z @ f_w1 + f_b1))
    h = jnp.sin(f_freq * (h @ f_w2 + f_b2))
    h = (h @ f_w3).astype(jnp.float32).reshape(L, HYENA_ORDER, 2, HY_W)
    deltas = jnp.abs(jnp.linspace(MIN_DECAY, MAX_DECAY, HY_W, dtype=jnp.float32))
    h = h * jnp.exp(-t[:, :, None, None] * deltas)
    h = h / (jnp.sum(jnp.abs(h), axis=0, keepdims=True) + EPS)
    fwd = h[:, :, 0]
    bwd = h[:, :, 1]
    k2 = jnp.concatenate([fwd, jnp.zeros_like(fwd[:1]), bwd[:0:-1]], axis=0)
    return jnp.fft.rfft(k2, axis=0)


def _long_conv(z, kf):
    L = z.shape[1]
    zf = jnp.fft.rfft(z.astype(jnp.float32), n=2 * L, axis=1)
    y = jnp.fft.irfft(zf * kf[None], n=2 * L, axis=1)[:, :L]
    return y.astype(z.dtype)


def _hyena_mix(hin, conv_w, conv_b, kf, hy_bias):
    hc = _short_conv(hin, conv_w, conv_b)
    v, x1, x2 = jnp.split(hc, 3, axis=-1)
    z = v
    for o, xg in enumerate((x1, x2)):
        z = xg * (_long_conv(z, kf[:, o]) + hy_bias[o] * z)
    return z


def _branches_residual(x, proj, gate, att, conv_w, conv_b, kf, hy_bias, w_br, w_out):
    B, L, _ = x.shape
    y_a = att.reshape(B, L, ATT_W) * jax.nn.silu(proj[..., OFF_GA:OFF_UB])
    y_b = _fourier_mix(proj[..., OFF_UB:OFF_GB]) * jax.nn.silu(proj[..., OFF_GB:OFF_HC])
    y_c = (_hyena_mix(proj[..., OFF_HC:OFF_GC], conv_w, conv_b, kf, hy_bias)
           * jax.nn.silu(proj[..., OFF_GC:OFF_MG]))
    g_a, g_b, g_c = jnp.split(jax.nn.sigmoid(proj[..., OFF_MG:]), 3, axis=-1)
    merged = (g_a * (y_a @ w_br[:ATT_W])
              + g_b * (y_b @ w_br[ATT_W:ATT_W + FNET_W])
              + g_c * (y_c @ w_br[ATT_W + FNET_W:]))
    return x + gate[:, None, :] * (merged @ w_out)


def setup_inputs(seed: int = 0) -> dict:
    key = jax.random.key(seed)
    ks = jax.random.split(key, 24)
    nrm = jax.random.normal
    f32 = jnp.float32
    return {
        'x_prompt': nrm(ks[0], (BATCH, SEQ, D_MODEL), f32),
        'x_sample': nrm(ks[1], (DEC_BATCH, DEC_SEQ, D_MODEL), f32),
        'cache_k': nrm(ks[2], (DEC_BATCH, DEPTH, PAST_LEN, N_HEADS, HEAD_DIM), f32),
        'cache_v': nrm(ks[3], (DEC_BATCH, DEPTH, PAST_LEN, N_HEADS, HEAD_DIM), f32),
        'c': nrm(ks[4], (DEC_BATCH, D_MODEL), f32),
        'c_ctx': nrm(ks[5], (D_MODEL,), f32),
        'norm_g': 1.0 + 0.01 * nrm(ks[6], (DEPTH, D_MODEL), f32),
        'w_ada': nrm(ks[7], (DEPTH, D_MODEL, 3 * D_MODEL), f32) * D_MODEL ** -0.5,
        'b_ada': 0.02 * nrm(ks[8], (DEPTH, 3 * D_MODEL), f32),
        'w_in': nrm(ks[9], (DEPTH, D_MODEL, N_IN), f32) * D_MODEL ** -0.5,
        'q_norm_g': 1.0 + 0.01 * nrm(ks[10], (DEPTH, HEAD_DIM), f32),
        'k_norm_g': 1.0 + 0.01 * nrm(ks[11], (DEPTH, HEAD_DIM), f32),
        'rpb': 0.1 * nrm(ks[12], (DEPTH, N_HEADS, 2 * MAX_KH - 1, 2 * KW - 1), f32),
        'conv_w': nrm(ks[13], (DEPTH, 3, 3 * HY_W), f32) * 3 ** -0.5,
        'conv_b': 0.02 * nrm(ks[14], (DEPTH, 3 * HY_W), f32),
        'f_w1': nrm(ks[15], (DEPTH, FILTER_EMB, FILTER_FF), f32) * FILTER_EMB ** -0.5,
        'f_b1': 0.1 * nrm(ks[16], (DEPTH, FILTER_FF), f32),
        'f_freq': 1.0 + 0.01 * nrm(ks[17], (DEPTH, FILTER_FF), f32),
        'f_w2': nrm(ks[18], (DEPTH, FILTER_FF, FILTER_FF), f32) * FILTER_FF ** -0.5,
        'f_b2': 0.1 * nrm(ks[19], (DEPTH, FILTER_FF), f32),
        'f_w3': nrm(ks[20], (DEPTH, FILTER_FF, HYENA_ORDER * 2 * HY_W), f32) * FILTER_FF ** -0.5,
        'hy_bias': 0.5 * nrm(ks[21], (DEPTH, HYENA_ORDER, HY_W), f32),
        'w_br': nrm(ks[22], (DEPTH, W_MIX, D_MODEL), f32) * ATT_W ** -0.5,
        'w_out': nrm(ks[23], (DEPTH, D_MODEL, D_MODEL), f32) * D_MODEL ** -0.5,
    }


def reference(x_prompt, x_sample, cache_k, cache_v, c, c_ctx, norm_g, w_ada, b_ada, w_in,
              q_norm_g, k_norm_g, rpb, conv_w, conv_b, f_w1, f_b1, f_freq, f_w2, f_b2,
              f_w3, hy_bias, w_br, w_out):
    len_prompt = x_prompt.shape[1]
    len_sample = x_sample.shape[1]

    y = x_prompt
    ks, vs = [], []
    for l in range(DEPTH):
        proj, gate = _modulated_proj(y, c_ctx[None, :], norm_g[l], w_ada[l], b_ada[l], w_in[l])
        q, k, v = _qkv(proj, q_norm_g[l], k_norm_g[l])
        ks.append(k)
        vs.append(v)
        att = _context_attention(q, k, v)
        kf = _hyena_filter_fft(len_prompt, f_w1[l], f_b1[l], f_freq[l], f_w2[l], f_b2[l], f_w3[l])
        y = _branches_residual(y, proj, gate, att, conv_w[l], conv_b[l], kf, hy_bias[l],
                               w_br[l], w_out[l])
    new_k = jnp.stack(ks, axis=1)
    new_v = jnp.stack(vs, axis=1)

    z = x_sample
    for l in range(DEPTH):
        proj, gate = _modulated_proj(z, c, norm_g[l], w_ada[l], b_ada[l], w_in[l])
        q, k, v = _qkv(proj, q_norm_g[l], k_norm_g[l])
        att = _latent_attention(q, k, v, cache_k[:, l], cache_v[:, l], rpb[l])
        kf = _hyena_filter_fft(len_sample, f_w1[l], f_b1[l], f_freq[l], f_w2[l], f_b2[l], f_w3[l])
        z = _branches_residual(z, proj, gate, att, conv_w[l], conv_b[l], kf, hy_bias[l],
                               w_br[l], w_out[l])

    return (y, z, new_k, new_v)
```

```cpp
#include <hip/hip_runtime.h>
#include <hip/hip_cooperative_groups.h>
#include <cstdio>
#include <cstdint>
namespace cg = cooperative_groups;

namespace pg8 {
#define PG8_LAS __attribute__((address_space(3)))
typedef unsigned short bf16_t;
typedef short bf16x8 __attribute__((ext_vector_type(8)));
typedef float f32x4 __attribute__((ext_vector_type(4)));
typedef unsigned u32x4 __attribute__((ext_vector_type(4)));
constexpr int BM = 256, BK = 64, HALF = 128, HTB = HALF * BK * 2  , STAGE_BYTES = 8 * HTB, NXCD = 8, WGM = 4;

__host__ __device__ __forceinline__ int lds_byte(int r, int c) { const int st = (r >> 4) * 2 + (c >> 5), rr = r & 15, cc = c & 31, ob = rr * 64 + cc * 2; return st * 1024 + (ob ^ (((ob >> 9) & 1) << 5)); }
__host__ __device__ __forceinline__ void stage_rc(int b, int& R, int& C) { const int st = b / 1024, sb = b % 1024, swz = sb ^ (((sb >> 9) & 1) << 5); R = (st >> 1) * 16 + swz / 64; C = (st & 1) * 32 + (swz % 64) / 2; }
__host__ __device__ __forceinline__ int perm32(int rho) { const int n = rho >> 4, i = rho & 15; return 8 * (i >> 2) + 4 * n + (i & 3); }

struct Unit { int pm, pn, kind; };
struct Gemm { const bf16_t* A; const bf16_t* Bt; int M, N, K; const bf16_t* A2; const bf16_t* Bt2; };

struct StaticOrder {
    int nM, nN, nwg, G, c;
    __host__ __device__ void init(int M, int N, int G_, int c_) { nM = M / BM; nN = N / BM; nwg = nM * nN; G = G_; c = c_; }
    __host__ __device__ bool next(int i, Unit& u) const {
        const long L = (long)i * G + c; if (L >= nwg) return false;
        int wgid = (int)L; { const int q = nwg / NXCD, r = nwg % NXCD, xcd = wgid % NXCD, off = wgid / NXCD; wgid = (xcd < r ? xcd * (q + 1) : r * (q + 1) + (xcd - r) * q) + off; }
        const int nig = WGM * nN, gid = wgid / nig, fm = gid * WGM, gsz = (nM - fm) < WGM ? (nM - fm) : WGM;
        u.pm = fm + ((wgid % nig) % gsz); u.pn = (wgid % nig) / gsz; u.kind = 0; return true;
    }
    __device__ __forceinline__ void a_ready(const Unit&) const {}
    __device__ __forceinline__ void done(const Unit&) const {}
};

__device__ __forceinline__ unsigned cvt_pk_bf16(float lo, float hi) { unsigned r; asm volatile("v_cvt_pk_bf16_f32 %0, %1, %2" : "=v"(r) : "v"(lo), "v"(hi)); return r; }
struct OneUnit {
    Unit u;
    __device__ bool next(int i, Unit& o) const { if (i != 0) return false; o = u; return true; }
    __device__ __forceinline__ void a_ready(const Unit&) const {}
    __device__ __forceinline__ void done(const Unit&) const {}
};
template <class Epi, class Sched, bool ALIGN_EPI = false, bool SP2 = false>
__device__ __forceinline__ void gemm_phase(PG8_LAS unsigned char* lds, const Gemm g, const Sched& S, const Epi& E) {
    int tid_o = threadIdx.x; asm volatile("" : "+v"(tid_o));
    const int tid = tid_o, wid = __builtin_amdgcn_readfirstlane(tid >> 6), lane = tid & 63, wr = wid >> 2, wc = wid & 3, fr = lane & 15, fq = lane >> 4;
    const int K = g.K, nt = K / BK;
    unsigned voffA[2], voffB[2];
#pragma unroll
    for (int i = 0; i < 2; ++i) { int R, C; stage_rc(tid * 16 + i * 8192, R, C); const int Rb = Epi::PERM ? ((R & ~31) + perm32(R & 31)) : R;
        voffA[i] = (unsigned)(R * K + C) * 2u; voffB[i] = (unsigned)(Rb * K + C) * 2u; }
    const size_t kstep = (size_t)(BK * 2);
    const size_t hstep = (size_t)HALF * K * 2;
    const size_t tstep = 2 * hstep;
    const unsigned ldsw = (unsigned)wid * 1024u;
    const int aoff = lds_byte(wr * 64 + fr, fq * 8), boff = lds_byte(wc * 32 + fr, fq * 8);
#define PG8_SA(b, h) (((b) * 2 + (h)) * HTB)
#define PG8_SB(b, h) ((4 + (b) * 2 + (h)) * HTB)
#define PG8_STAGE(bufoff, gbase, voff) do { _Pragma("unroll") for (int _i = 0; _i < 2; ++_i) \
        __builtin_amdgcn_global_load_lds((const unsigned*)((const char*)(gbase) + (voff)[_i]), (PG8_LAS unsigned*)(lds + (bufoff) + ldsw + _i * 8192), 16, 0, 0); } while (0)
#define PG8_LDA(dst, b, h) do { _Pragma("unroll") for (int m = 0; m < 4; ++m) _Pragma("unroll") for (int k = 0; k < 2; ++k) dst[m][k] = *(const PG8_LAS bf16x8*)(lds + PG8_SA(b, h) + aoff + m * 2048 + k * 1024); } while (0)
#define PG8_LDB(dst, b, h) do { _Pragma("unroll") for (int n = 0; n < 2; ++n) _Pragma("unroll") for (int k = 0; k < 2; ++k) dst[n][k] = *(const PG8_LAS bf16x8*)(lds + PG8_SB(b, h) + boff + n * 2048 + k * 1024); } while (0)
#define PG8_MMA(ai, bj, At, Bt) do { __builtin_amdgcn_s_setprio(1); _Pragma("unroll") for (int m = 0; m < 4; ++m) _Pragma("unroll") for (int n = 0; n < 2; ++n) _Pragma("unroll") for (int k = 0; k < 2; ++k) \
        acc[ai][bj][m][n] = __builtin_amdgcn_mfma_f32_16x16x32_bf16(Bt[n][k], At[m][k], acc[ai][bj][m][n], 0, 0, 0); __builtin_amdgcn_s_setprio(0); } while (0)
#define PG8_WAIT_V(n) asm volatile("s_waitcnt vmcnt(" #n ")" ::: "memory")
#define PG8_WAIT_L(n) asm volatile("s_waitcnt lgkmcnt(" #n ")" ::: "memory")
#define PG8_BAR __builtin_amdgcn_s_barrier()
#define PG8_SCHED __builtin_amdgcn_sched_barrier(0)
    Unit cur, nxt; int ui = 0;
    if (!S.next(0, cur)) return;
    f32x4 acc[2][2][4][2];
#pragma unroll
    for (int a = 0; a < 2; ++a)
#pragma unroll
        for (int b = 0; b < 2; ++b)
#pragma unroll
            for (int m = 0; m < 4; ++m)
#pragma unroll
                for (int n = 0; n < 2; ++n) acc[a][b][m][n] = (f32x4){0.f, 0.f, 0.f, 0.f};
    bf16x8 At[4][2], B0[2][2], B1[2][2];
    const char* cA = (const char*)(cur.kind ? g.A2 : g.A) + (size_t)cur.pm * tstep; const char* cB = (const char*)(cur.kind ? g.Bt2 : g.Bt) + (size_t)cur.pn * tstep;
    S.a_ready(cur);
    if constexpr (SP2) {
        PG8_STAGE(PG8_SB(0, 0), cB, voffB); PG8_STAGE(PG8_SB(0, 1), cB + hstep, voffB); PG8_STAGE(PG8_SA(0, 0), cA, voffA); PG8_STAGE(PG8_SA(0, 1), cA + hstep, voffA);
        if (wr == 1) PG8_BAR;
        PG8_WAIT_V(2); PG8_BAR;
        PG8_STAGE(PG8_SB(1, 0), cB + kstep, voffB); PG8_STAGE(PG8_SA(1, 0), cA + kstep, voffA); PG8_STAGE(PG8_SB(1, 1), cB + hstep + kstep, voffB);
        PG8_WAIT_V(6); PG8_BAR;
    } else {
        PG8_STAGE(PG8_SB(0, 0), cB, voffB); PG8_STAGE(PG8_SA(0, 0), cA, voffA); PG8_STAGE(PG8_SB(0, 1), cB + hstep, voffB); PG8_STAGE(PG8_SA(0, 1), cA + hstep, voffA);
        if (wr == 1) PG8_BAR;
        PG8_WAIT_V(4); PG8_BAR;
        PG8_STAGE(PG8_SB(1, 0), cB + kstep, voffB); PG8_STAGE(PG8_SA(1, 0), cA + kstep, voffA); PG8_STAGE(PG8_SB(1, 1), cB + hstep + kstep, voffB);
        PG8_WAIT_V(6); PG8_BAR;
    }
    for (;;) {
        const bool has_next = S.next(ui + 1, nxt);
        const char* nA = has_next ? (const char*)(nxt.kind ? g.A2 : g.A) + (size_t)nxt.pm * tstep : cA; const char* nB = has_next ? (const char*)(nxt.kind ? g.Bt2 : g.Bt) + (size_t)nxt.pn * tstep : cB;
        for (int t = 0; t < nt; t += 2) {
            const bool last = (t == nt - 2);
            if constexpr (Epi::HOOK) { if (cur.kind == 0 && (t == Epi::HK0 || t == Epi::HK1)) E.hook(acc, cur, t, wr, wc, fr, fq); }
            const char* a1 = cA + (size_t)(t + 1) * kstep;
            const char* a2 = last ? nA : cA + (size_t)(t + 2) * kstep; const char* b2 = last ? nB : cB + (size_t)(t + 2) * kstep;
            const char* a3 = a2 + kstep; const char* b3 = b2 + kstep;
            if (last && has_next) S.a_ready(nxt);
            if constexpr (SP2) {
            PG8_LDB(B0, 0, 0); PG8_LDB(B1, 0, 1); PG8_SCHED; PG8_LDA(At, 0, 0); PG8_STAGE(PG8_SA(1, 1), a1 + hstep, voffA);
            PG8_WAIT_V(8); PG8_WAIT_L(0); PG8_BAR; PG8_MMA(0, 0, At, B0); PG8_MMA(0, 1, At, B1); PG8_BAR; PG8_SCHED;
            PG8_LDA(At, 0, 1); PG8_STAGE(PG8_SB(0, 0), b2, voffB); PG8_STAGE(PG8_SB(0, 1), b2 + hstep, voffB); PG8_STAGE(PG8_SA(0, 0), a2, voffA);
            PG8_WAIT_V(8); PG8_WAIT_L(0); PG8_BAR; PG8_MMA(1, 0, At, B0); PG8_MMA(1, 1, At, B1); PG8_BAR; PG8_SCHED;
            PG8_LDB(B0, 1, 0); PG8_LDB(B1, 1, 1); PG8_SCHED; PG8_LDA(At, 1, 0); PG8_STAGE(PG8_SA(0, 1), a2 + hstep, voffA);
            PG8_WAIT_V(8); PG8_WAIT_L(0); PG8_BAR; PG8_MMA(0, 0, At, B0); PG8_MMA(0, 1, At, B1); PG8_BAR; PG8_SCHED;
            PG8_LDA(At, 1, 1); PG8_STAGE(PG8_SB(1, 0), b3, voffB); PG8_STAGE(PG8_SB(1, 1), b3 + hstep, voffB); PG8_STAGE(PG8_SA(1, 0), a3, voffA);
            PG8_WAIT_V(8); PG8_WAIT_L(0); PG8_BAR; PG8_MMA(1, 0, At, B0); PG8_MMA(1, 1, At, B1); PG8_BAR; PG8_SCHED;
            } else {
            PG8_LDB(B0, 0, 0); PG8_SCHED; PG8_LDA(At, 0, 0); PG8_STAGE(PG8_SA(1, 1), a1 + hstep, voffA);
            PG8_WAIT_L(8); PG8_BAR; PG8_WAIT_L(0); PG8_MMA(0, 0, At, B0); PG8_BAR; PG8_SCHED;
            PG8_LDB(B1, 0, 1); PG8_STAGE(PG8_SB(0, 0), b2, voffB);
            PG8_BAR; PG8_WAIT_L(0); PG8_MMA(0, 1, At, B1); PG8_BAR;
            PG8_LDA(At, 0, 1); PG8_STAGE(PG8_SA(0, 0), a2, voffA);
            PG8_BAR; PG8_WAIT_L(0); PG8_MMA(1, 0, At, B0); PG8_BAR; PG8_SCHED;
            PG8_STAGE(PG8_SB(0, 1), b2 + hstep, voffB);
            PG8_WAIT_V(6); PG8_BAR; PG8_MMA(1, 1, At, B1); PG8_BAR;
            PG8_LDB(B0, 1, 0); PG8_SCHED; PG8_LDA(At, 1, 0); PG8_STAGE(PG8_SA(0, 1), a2 + hstep, voffA);
            PG8_WAIT_L(8); PG8_BAR; PG8_WAIT_L(0); PG8_MMA(0, 0, At, B0); PG8_BAR; PG8_SCHED;
            PG8_LDB(B1, 1, 1); PG8_STAGE(PG8_SB(1, 0), b3, voffB);
            PG8_BAR; PG8_WAIT_L(0); PG8_MMA(0, 1, At, B1); PG8_BAR;
            PG8_LDA(At, 1, 1); PG8_STAGE(PG8_SA(1, 0), a3, voffA);
            PG8_BAR; PG8_WAIT_L(0); PG8_MMA(1, 0, At, B0); PG8_BAR; PG8_SCHED;
            PG8_STAGE(PG8_SB(1, 1), b3 + hstep, voffB);
            PG8_WAIT_V(6); PG8_BAR; PG8_MMA(1, 1, At, B1); PG8_BAR;
            }
        }
        if constexpr (ALIGN_EPI) { if (wr == 0) PG8_BAR; }
        if constexpr (!Epi::AFTER_DRAIN) { E(acc, cur, wr, wc, fr, fq); S.done(cur); }
        if (!has_next) break;
#pragma unroll
        for (int a = 0; a < 2; ++a)
#pragma unroll
            for (int b = 0; b < 2; ++b)
#pragma unroll
                for (int m = 0; m < 4; ++m)
#pragma unroll
                    for (int n = 0; n < 2; ++n) acc[a][b][m][n] = (f32x4){0.f, 0.f, 0.f, 0.f};
        cur = nxt; cA = nA; cB = nB; ++ui;
        if constexpr (ALIGN_EPI) { if (wr == 1) PG8_BAR; }
    }
    PG8_WAIT_V(0);
    if constexpr (!ALIGN_EPI) { if (wr == 0) PG8_BAR; }
    PG8_BAR;
    if constexpr (Epi::AFTER_DRAIN) { E.fused(acc, cur, wr, wc, fr, fq, lds, wid, lane); S.done(cur); }
#undef PG8_SA
#undef PG8_SB
#undef PG8_STAGE
#undef PG8_LDA
#undef PG8_LDB
#undef PG8_MMA
#undef PG8_WAIT_V
#undef PG8_WAIT_L
#undef PG8_BAR
#undef PG8_SCHED
}
}

#define LAS __attribute__((address_space(3)))
typedef unsigned short bf16;
typedef float f32x4 __attribute__((ext_vector_type(4)));
typedef float f32x2 __attribute__((ext_vector_type(2)));
typedef short bf16x8 __attribute__((ext_vector_type(8)));
typedef short s16x4 __attribute__((ext_vector_type(4)));
typedef unsigned u32x4 __attribute__((ext_vector_type(4)));
typedef unsigned u32x2 __attribute__((ext_vector_type(2)));

constexpr int DM = 2048, NCTX = 8192, NLAT = 4096, MTOK = 12288, NIN = 13312, NH = 8, HD = 128;
constexpr int OFF_Q = 0, OFF_K = 1024, OFF_V = 2048, OFF_GA = 3072, OFF_UB = 4096, OFF_GB = 4608, OFF_HC = 5120, OFF_GC = 6656, OFF_MG = 7168;
constexpr float EPS = 1e-6f;
constexpr float MIN_DECAY = -3.0701134573253945f, MAX_DECAY = -15.350567286626973f;
constexpr int NTHR = 512, NWAVES = 8;
constexpr int LDS_BYTES = 147456;
constexpr int LDS_WORD_OFF = 147392;

constexpr size_t MiB = 1u << 20;
constexpr size_t WS_CTL = 0, CTL_BYTES = 65536;
constexpr size_t WS_ADA = 1 * MiB;
constexpr size_t WS_HID = 2 * MiB;
constexpr size_t WS_WIN = 4 * MiB;
constexpr size_t WS_WBR = 108 * MiB;
constexpr size_t WS_WOUT = 124 * MiB;
constexpr size_t WS_DFTC = 140 * MiB;
constexpr size_t WS_DFTL = 141 * MiB;
constexpr size_t WS_KF = 160 * MiB;
constexpr size_t KF_LK0 = (size_t)2 * 512 * 528;
constexpr size_t KF_LK1 = (size_t)2 * 512 * 4112;
constexpr size_t KF_LAYER = KF_LK0 + KF_LK1;
constexpr size_t WS_CKB = 180 * MiB, WS_CVB = 184 * MiB;
constexpr size_t WS_H = 306 * MiB;
constexpr size_t WS_P = 354 * MiB;
constexpr size_t WS_ZT = 666 * MiB;
constexpr size_t WS_HT = 678 * MiB;
constexpr size_t WS_YMIX = 726 * MiB;
constexpr size_t WS_END = 774 * MiB;
static_assert(WS_KF + 2 * KF_LAYER * 2 <= WS_H, "kf");

struct Params { const float* in[24]; float* out; unsigned char* ws; };
enum { I_XP = 0, I_XS, I_CK, I_CV, I_C, I_CCTX, I_NG, I_WADA, I_BADA, I_WIN, I_QG, I_KG, I_RPB, I_CW, I_CB, I_FW1, I_FB1, I_FFREQ, I_FW2, I_FB2, I_FW3, I_HYB, I_WBR, I_WOUT };

__device__ __forceinline__ float bf2f(unsigned b) { return __uint_as_float(b << 16); }
__device__ __forceinline__ unsigned f2bf(float f) { unsigned u = __float_as_uint(f); return (u + 0x7fffu + ((u >> 16) & 1u)) >> 16; }
__device__ __forceinline__ unsigned pk2(float lo, float hi) { return pg8::cvt_pk_bf16(lo, hi); }
__device__ __forceinline__ float wave_sum(float v) {
#pragma unroll
    for (int o = 1; o < 64; o <<= 1) v += __shfl_xor(v, o);
    return v;
}
__device__ __forceinline__ float sigmoidf_(float x) { return 1.0f / (1.0f + __expf(-x)); }
__device__ __forceinline__ float siluf_(float x) { return x / (1.0f + __expf(-x)); }
__device__ __forceinline__ void unpack8(u32x4 w, float* f) {
    f[0] = bf2f(w.x & 0xffffu); f[1] = bf2f(w.x >> 16); f[2] = bf2f(w.y & 0xffffu); f[3] = bf2f(w.y >> 16);
    f[4] = bf2f(w.z & 0xffffu); f[5] = bf2f(w.z >> 16); f[6] = bf2f(w.w & 0xffffu); f[7] = bf2f(w.w >> 16);
}

struct EpiG1 {
    static constexpr bool PERM = true, AFTER_DRAIN = false, HOOK = false; static constexpr int HK0 = -1, HK1 = -1;
    bf16* P; bf16* ZT; bf16* HT; float* newv; int layer;
    __device__ __forceinline__ void hook(pg8::f32x4 (&acc)[2][2][4][2], const pg8::Unit& u, int t, int wr, int wc, int fr, int fq) const {}
    __device__ __forceinline__ void operator()(const pg8::f32x4 (&acc)[2][2][4][2], const pg8::Unit& u, int wr, int wc, int fr, int fq) const {
        const int pn = u.pn;
        const int rowb = u.pm * 256 + wr * 64 + fr, colb = pn * 256 + wc * 32 + 8 * fq;
        const bool tr = (pn == 16) || (pn == 17) || (pn >= 20 && pn <= 27);
        if (!tr) {
            const bool nv = (pn >= 8 && pn < 12 && u.pm < 32);
#pragma unroll
            for (int ai = 0; ai < 2; ++ai)
#pragma unroll
                for (int m = 0; m < 4; ++m) {
                    const int row = rowb + ai * 128 + m * 16;
#pragma unroll
                    for (int bj = 0; bj < 2; ++bj) {
                        const int col = colb + bj * 128;
                        const pg8::f32x4 v0 = acc[ai][bj][m][0], v1 = acc[ai][bj][m][1];
                        u32x4 w; w.x = pk2(v0[0], v0[1]); w.y = pk2(v0[2], v0[3]); w.z = pk2(v1[0], v1[1]); w.w = pk2(v1[2], v1[3]);
                        *(u32x4*)(P + (size_t)row * NIN + col) = w;
                        if (nv) {
                            const int b = row >> 8, t = row & 255;
                            float* o = newv + ((size_t)((b * 2 + layer) * 256 + t)) * 1024 + (col - OFF_V);
                            *(pg8::f32x4*)o = v0; *(pg8::f32x4*)(o + 4) = v1;
                        }
                    }
                }
        } else {
            int chb, nch; bf16* dst;
            if (pn < 18) { chb = colb - OFF_UB; nch = 512; dst = ZT; }
            else if (pn < 26) { chb = colb - OFF_HC; nch = 2048; dst = HT; }
            else { chb = 1536 + colb - OFF_GC; nch = 2048; dst = HT; }
            size_t base; int L;
            if (u.pm < 32) { L = 256; base = (size_t)u.pm * nch * 256; }
            else { L = 2048; const int lr = (u.pm - 32) * 256; base = (size_t)32 * nch * 256 + (size_t)(lr >> 11) * nch * 2048 + (lr & 2047); }
            const int posb = wr * 64 + fr;
#pragma unroll
            for (int ai = 0; ai < 2; ++ai)
#pragma unroll
                for (int m = 0; m < 4; ++m) {
                    const int pos = posb + ai * 128 + m * 16;
#pragma unroll
                    for (int bj = 0; bj < 2; ++bj) {
                        const int ch = chb + bj * 128;
#pragma unroll
                        for (int n = 0; n < 2; ++n)
#pragma unroll
                            for (int e = 0; e < 4; ++e)
                                dst[base + (size_t)(ch + 4 * n + e) * L + pos] = (bf16)f2bf(acc[ai][bj][m][n][e]);
                    }
                }
        }
    }
};

struct EpiG2 {
    static constexpr bool PERM = true, AFTER_DRAIN = false, HOOK = true; static constexpr int HK0 = 16, HK1 = 24;
    const bf16* P; bf16* MG;
    __device__ __forceinline__ void hook(pg8::f32x4 (&acc)[2][2][4][2], const pg8::Unit& u, int t, int wr, int wc, int fr, int fq) const {
        const int seg = (t == HK0) ? 0 : 1;
        int zo = 0; asm volatile("" : "+v"(zo));
        const int rowb = u.pm * 256 + wr * 64 + fr + zo, colb = u.pn * 256 + wc * 32 + 8 * fq;
        const bf16* pn_ = P + OFF_MG + seg * 2048 + colb; const bf16* pd_ = pn_ + 2048;
        u32x4 wn[2][2][2], wd[2][2][2];
#define G2_LOAD(buf, k) do { _Pragma("unroll") for (int m2 = 0; m2 < 2; ++m2) { const size_t ro = (size_t)(rowb + ((k) >> 1) * 128 + (((k) & 1) * 2 + m2) * 16) * NIN; \
            _Pragma("unroll") for (int bj = 0; bj < 2; ++bj) { wn[buf][m2][bj] = *(const u32x4*)(pn_ + ro + bj * 128); wd[buf][m2][bj] = *(const u32x4*)(pd_ + ro + bj * 128); } } } while (0)
        G2_LOAD(0, 0);
#pragma unroll
        for (int k = 0; k < 4; ++k) {
            const int ai = k >> 1, mh = k & 1;
            if (k < 3) G2_LOAD((k + 1) & 1, k + 1);
#pragma unroll
            for (int m2 = 0; m2 < 2; ++m2)
#pragma unroll
                for (int bj = 0; bj < 2; ++bj) {
                    float fn[8], fd[8]; unpack8(wn[k & 1][m2][bj], fn); unpack8(wd[k & 1][m2][bj], fd);
#pragma unroll
                    for (int e = 0; e < 8; ++e) { const float r = (1.0f + __expf(-fd[e])) * __builtin_amdgcn_rcpf(1.0f + __expf(-fn[e])); acc[ai][bj][mh * 2 + m2][e >> 2][e & 3] *= r; }
                }
            asm volatile("" ::: "memory");
        }
#undef G2_LOAD
    }
    __device__ __forceinline__ void operator()(const pg8::f32x4 (&acc)[2][2][4][2], const pg8::Unit& u, int wr, int wc, int fr, int fq) const {
        const int rowb = u.pm * 256 + wr * 64 + fr, colb = u.pn * 256 + wc * 32 + 8 * fq;
#pragma unroll
        for (int ai = 0; ai < 2; ++ai) {
            u32x4 wg[4][2];
#pragma unroll
            for (int m = 0; m < 4; ++m)
#pragma unroll
                for (int bj = 0; bj < 2; ++bj) wg[m][bj] = *(const u32x4*)(P + (size_t)(rowb + ai * 128 + m * 16) * NIN + OFF_MG + 4096 + colb + bj * 128);
#pragma unroll
            for (int m = 0; m < 4; ++m) {
                const int row = rowb + ai * 128 + m * 16;
#pragma unroll
                for (int bj = 0; bj < 2; ++bj) {
                    const int col = colb + bj * 128;
                    float g[8]; unpack8(wg[m][bj], g);
                    float v[8];
#pragma unroll
                    for (int e = 0; e < 8; ++e) v[e] = acc[ai][bj][m][e >> 2][e & 3] * sigmoidf_(g[e]);
                    u32x4 w; w.x = pk2(v[0], v[1]); w.y = pk2(v[2], v[3]); w.z = pk2(v[4], v[5]); w.w = pk2(v[6], v[7]);
                    *(u32x4*)(MG + (size_t)row * DM + col) = w;
                }
            }
            asm volatile("" ::: "memory");
        }
    }
};

struct EpiG3 {
    static constexpr bool PERM = true, AFTER_DRAIN = false, HOOK = false; static constexpr int HK0 = -1, HK1 = -1;
    const float* xc; const float* xl; float* out; const float* ada_l;
    __device__ __forceinline__ void hook(pg8::f32x4 (&acc)[2][2][4][2], const pg8::Unit& u, int t, int wr, int wc, int fr, int fq) const {}
    __device__ __forceinline__ void operator()(const pg8::f32x4 (&acc)[2][2][4][2], const pg8::Unit& u, int wr, int wc, int fr, int fq) const {
        const int rowb = u.pm * 256 + wr * 64 + fr, colb = u.pn * 256 + wc * 32 + 8 * fq;
        const bool isc = u.pm < 32;
        const int cv = isc ? 0 : 1 + ((u.pm - 32) >> 3);
        const float* gate = ada_l + cv * 6144 + 4096;
        const float* xb = isc ? xc : xl - (size_t)NCTX * DM;
        pg8::f32x4 gv[2][2];
#pragma unroll
        for (int bj = 0; bj < 2; ++bj)
#pragma unroll
            for (int n = 0; n < 2; ++n) gv[bj][n] = *(const pg8::f32x4*)(gate + colb + bj * 128 + n * 4);
#pragma unroll
        for (int ai = 0; ai < 2; ++ai)
#pragma unroll
            for (int m = 0; m < 4; ++m) {
                const size_t ro = (size_t)(rowb + ai * 128 + m * 16) * DM;
#pragma unroll
                for (int bj = 0; bj < 2; ++bj)
#pragma unroll
                    for (int n = 0; n < 2; ++n) {
                        const int col = colb + bj * 128 + n * 4;
                        const pg8::f32x4 xv = *(const pg8::f32x4*)(xb + ro + col);
                        *(pg8::f32x4*)(out + ro + col) = xv + gv[bj][n] * acc[ai][bj][m][n];
                    }
                if (m == 3) asm volatile("" ::: "memory");
            }
    }
};
struct EpiG23 {
    static constexpr bool PERM = true, AFTER_DRAIN = false, HOOK = true; static constexpr int HK0 = 16, HK1 = 24;
    EpiG2 e2; EpiG3 e3;
    __device__ __forceinline__ void hook(pg8::f32x4 (&acc)[2][2][4][2], const pg8::Unit& u, int t, int wr, int wc, int fr, int fq) const { e2.hook(acc, u, t, wr, wc, fr, fq); }
    __device__ __forceinline__ void operator()(const pg8::f32x4 (&acc)[2][2][4][2], const pg8::Unit& u, int wr, int wc, int fr, int fq) const {
        if (u.kind == 0) e2(acc, u, wr, wc, fr, fq); else e3(acc, u, wr, wc, fr, fq);
    }
};
struct Order23 {
    int G, c; unsigned* cnt;
    __device__ bool next(int i, pg8::Unit& u) const { const int v = i * G + ((G == 256) ? 32 * (c & 7) + (c >> 3) : c); if (v >= 768) return false;     const int k = v >= 384 ? 1 : 0, w = v - 384 * k; u.pm = w >> 3; u.pn = w & 7; u.kind = k; return true; }
    __device__ __forceinline__ void a_ready(const pg8::Unit& u) const {
        if (u.kind) {
            unsigned* cp = cnt + 64 * u.pm; unsigned sp = 0;
            while (__hip_atomic_load(cp, __ATOMIC_RELAXED, __HIP_MEMORY_SCOPE_AGENT) < 64u) { __builtin_amdgcn_s_sleep(2); if (++sp > (1u << 22)) break; }
            __builtin_amdgcn_fence(__ATOMIC_ACQUIRE, "agent");
            asm volatile("s_waitcnt vmcnt(0)" ::: "memory");
        }
    }
    __device__ __forceinline__ void done(const pg8::Unit& u) const {
        if (!u.kind) {
            asm volatile("s_waitcnt vmcnt(0)" ::: "memory");
            __builtin_amdgcn_s_barrier();
            if (threadIdx.x < 64) {
                __builtin_amdgcn_fence(__ATOMIC_RELEASE, "agent");
                asm volatile("s_waitcnt vmcnt(0)" ::: "memory");
                if (threadIdx.x == 0) __hip_atomic_fetch_add(cnt + 64 * u.pm, 8u, __ATOMIC_RELAXED, __HIP_MEMORY_SCOPE_AGENT);
            }
        }
    }
};

struct EpiF {
    static constexpr bool PERM = false, AFTER_DRAIN = false, HOOK = false; static constexpr int HK0 = -1, HK1 = -1;
    const bf16* P; bf16* Y; int lat;
    __device__ __forceinline__ void hook(pg8::f32x4 (&acc)[2][2][4][2], const pg8::Unit& u, int t, int wr, int wc, int fr, int fq) const {}
    __device__ __forceinline__ void operator()(const pg8::f32x4 (&acc)[2][2][4][2], const pg8::Unit& u, int wr, int wc, int fr, int fq) const {
        const int batch = u.pn >> 1, gb = (u.pn & 1) * 2;
        const int tok0 = lat ? NCTX + batch * 2048 : batch * 256;
#pragma unroll
        for (int m = 0; m < 4; ++m) {
            const int k = u.pm * 128 + wr * 64 + m * 16 + fr;
            const size_t tok = (size_t)(tok0 + k);
#pragma unroll
            for (int bj = 0; bj < 2; ++bj) {
                const int g = gb + bj;
                const bf16* gp = P + tok * NIN + OFF_GB + g * 128;
                bf16* yp = Y + tok * DM + 1024 + g * 128;
#pragma unroll
                for (int n = 0; n < 2; ++n) {
                    const pg8::f32x4 C = acc[0][bj][m][n], S = acc[1][bj][m][n];
                    const int s0 = wc * 32 + n * 16 + fq * 4;
#pragma unroll
                    for (int pr = 0; pr < 2; ++pr) {
                        const int s = s0 + 2 * pr;
                        const float ce = C[2 * pr], co = C[2 * pr + 1], so = S[2 * pr + 1];
                        int c0, c1; float y0, y1;
                        if (s == 0) { c0 = 0; c1 = 64; y0 = ce; y1 = co; }
                        else { c0 = s >> 1; c1 = 128 - c0; y0 = ce - so; y1 = ce + so; }
                        yp[c0] = (bf16)f2bf(y0 * siluf_(bf2f(gp[c0])));
                        yp[c1] = (bf16)f2bf(y1 * siluf_(bf2f(gp[c1])));
                    }
                }
            }
        }
    }
};

__device__ __forceinline__ void p0_transpose_item(const float* W, int K, int N, bf16* WT, LAS float* scr, int kb, int nb, int lane) {
    const int k0 = 64 * kb, n0 = 32 * nb;
#pragma unroll
    for (int i = 0; i < 32; ++i) { const int kk = 2 * i + (lane >> 5); scr[kk * 33 + (lane & 31)] = W[(size_t)(k0 + kk) * N + n0 + (lane & 31)]; }
    asm volatile("s_waitcnt lgkmcnt(0)" ::: "memory");
    const int c = lane & 7;
#pragma unroll
    for (int j = 0; j < 4; ++j) { const int n = (lane >> 3) + 8 * j; const LAS float* s = scr + (8 * c) * 33 + n;
        u32x4 o; o.x = pk2(s[0 * 33], s[1 * 33]); o.y = pk2(s[2 * 33], s[3 * 33]); o.z = pk2(s[4 * 33], s[5 * 33]); o.w = pk2(s[6 * 33], s[7 * 33]);
        *(u32x4*)(WT + (size_t)(n0 + n) * K + k0 + 8 * c) = o; }
    asm volatile("s_waitcnt lgkmcnt(0)" ::: "memory");
}

__device__ __forceinline__ void ada_item(const Params& p, LAS unsigned char* lds, const int tid, int it) {
    const int lane = tid & 63, wave = tid >> 6;
    LAS float* sc = (LAS float*)lds; LAS float* red = (LAS float*)(lds + 24576);
    float* ada = (float*)(p.ws + WS_ADA);
    const int l = it / 96, cgp = it % 96;
    __syncthreads();
    for (int i = tid; i < 3 * 2048; i += NTHR) { const int cv = i >> 11, k = i & 2047; const float v = cv == 0 ? p.in[I_CCTX][k] : p.in[I_C][(cv - 1) * 2048 + k]; sc[i] = siluf_(v); }
    __syncthreads();
    const int col = cgp * 64 + lane, kp = wave;
    const float* w = p.in[I_WADA] + (size_t)l * 2048 * 6144 + (size_t)(kp * 256) * 6144 + col;
    float a0 = 0.f, a1 = 0.f, a2 = 0.f;
#pragma unroll 32
    for (int k = 0; k < 256; ++k) { const float wv = w[(size_t)k * 6144]; a0 += sc[kp * 256 + k] * wv; a1 += sc[2048 + kp * 256 + k] * wv; a2 += sc[4096 + kp * 256 + k] * wv; }
    red[(kp * 64 + lane) * 3 + 0] = a0; red[(kp * 64 + lane) * 3 + 1] = a1; red[(kp * 64 + lane) * 3 + 2] = a2;
    __syncthreads();
    if (tid < 192) { const int cv = tid / 64, cc = tid % 64; float s = 0.f;
#pragma unroll
        for (int q = 0; q < 8; ++q) s += red[(q * 64 + cc) * 3 + cv];
        ada[(l * 3 + cv) * 6144 + cgp * 64 + cc] = s + p.in[I_BADA][l * 6144 + cgp * 64 + cc]; }
}
__device__ __forceinline__ void fold_item(const Params& p, LAS unsigned char* lds, const int tid, int it) {
    const int lane = tid & 63, wave = tid >> 6;
    LAS float* Wsub = (LAS float*)lds; LAS float* ctab = (LAS float*)(lds + 64 * 129 * 4); LAS float* stab = ctab + 128;
    bf16* WT = (bf16*)(p.ws + WS_WIN);
    const int l = it >> 7, kb = (it >> 2) & 31, g = it & 3;
    __syncthreads();
    if (tid < 128) { ctab[tid] = cospif((float)tid * (1.0f / 64.0f)); stab[tid] = sinpif((float)tid * (1.0f / 64.0f)); }
    for (int i = tid; i < 64 * 128; i += NTHR) { const int kk = i >> 7, cc = i & 127; Wsub[kk * 129 + cc] = p.in[I_WIN][((size_t)l * 2048 + kb * 64 + kk) * NIN + OFF_UB + g * 128 + cc]; }
    __syncthreads();
    for (int si = 0; si < 16; ++si) {
        const int slot = wave * 16 + si;
        int m; bool isS; if (slot == 0) { m = 0; isS = false; } else if (slot == 1) { m = 64; isS = false; } else { m = slot >> 1; isS = (slot & 1) != 0; }
        const LAS float* tab = isS ? stab : ctab;
        float a = 0.f;
#pragma unroll 8
        for (int cc = 0; cc < 128; ++cc) a += Wsub[lane * 129 + cc] * tab[(m * cc) & 127];
        a *= 0.08838834764831845f;
        WT[((size_t)l * NIN + OFF_UB + g * 128 + slot) * 2048 + kb * 64 + lane] = (bf16)f2bf(a);
    }
}
constexpr int TR_IN = 32 * 416, TR_SQ = 32 * 64, TR_LAYER = TR_IN + 2 * TR_SQ;
__device__ __forceinline__ void transpose_witem(const Params& p, LAS float* scr, const int lane, int it) {
    const int l = it / TR_LAYER; int r = it % TR_LAYER;
    if (r < TR_IN) { const int kb = r / 416, nb = r % 416;
        if (nb >= 128 && nb < 144) return;
        p0_transpose_item(p.in[I_WIN] + (size_t)l * 2048 * NIN, 2048, NIN, (bf16*)(p.ws + WS_WIN) + (size_t)l * NIN * 2048, scr, kb, nb, lane); return; }
    r -= TR_IN;
    if (r < TR_SQ) { p0_transpose_item(p.in[I_WBR] + (size_t)l * 2048 * 2048, 2048, 2048, (bf16*)(p.ws + WS_WBR) + (size_t)l * 2048 * 2048, scr, r / 64, r % 64, lane); return; }
    r -= TR_SQ;
    p0_transpose_item(p.in[I_WOUT] + (size_t)l * 2048 * 2048, 2048, 2048, (bf16*)(p.ws + WS_WOUT) + (size_t)l * 2048 * 2048, scr, r / 64, r % 64, lane);
}

__device__ __forceinline__ void phase0(const Params& p, LAS unsigned char* lds) {
    int tid_o = threadIdx.x; asm volatile("" : "+v"(tid_o));
    const int tid = tid_o, lane = tid & 63, wave = tid >> 6;
    const int G = gridDim.x, bid = blockIdx.x;
    unsigned char* ws = p.ws;
    for (int it = bid; it < 192; it += G) ada_item(p, lds, tid, it);
    for (int it = bid; it < 256; it += G) fold_item(p, lds, tid, it);
    __syncthreads();
    {
        LAS float* scr = (LAS float*)(lds + wave * 16384);
        const int gw = bid * NWAVES + wave, NGW = G * NWAVES;
        for (int it = gw; it < 2 * TR_LAYER; it += NGW) transpose_witem(p, scr, lane, it);
        float* HID = (float*)(ws + WS_HID);
        for (int r = gw; r < 2 * 2304; r += NGW) {
            const int l = r / 2304, rr = r % 2304, lk = rr < 256 ? 0 : 1, t = lk ? rr - 256 : rr, L = lk ? 2048 : 256;
            const float tt = (float)t / (float)(L - 1), w = (6.283185307179586f / (float)L) * (float)t;
            const float fstep = (15.0f - 1e-4f) / 15.0f;
            float zi = 0.f;
            if (lane == 0) zi = tt; else if (lane <= 16) zi = cosf(w * (1e-4f + (float)(lane - 1) * fstep)); else if (lane <= 32) zi = -sinf(w * (1e-4f + (float)(lane - 17) * fstep));
            const float fr_ = p.in[I_FFREQ][l * 64 + lane];
            float a = p.in[I_FB1][l * 64 + lane];
            for (int i = 0; i < 33; ++i) a += __shfl(zi, i) * p.in[I_FW1][(l * 33 + i) * 64 + lane];
            const float h1 = sinf(fr_ * a);
            float a2 = p.in[I_FB2][l * 64 + lane];
            for (int i = 0; i < 64; ++i) a2 += __shfl(h1, i) * p.in[I_FW2][(l * 64 + i) * 64 + lane];
            HID[((size_t)(l * 2 + lk) * 2048 + t) * 64 + lane] = sinf(fr_ * a2);
        }
    }
    {
        bf16* ckb = (bf16*)(ws + WS_CKB); bf16* cvb = (bf16*)(ws + WS_CVB);
        const int nch = 2 * 2 * 512 * 1024 / 8;
        for (int ch = bid * NTHR + tid; ch < 2 * nch; ch += G * NTHR) {
            const int which = ch >= nch, i = (which ? ch - nch : ch) * 8;
            const float* src = (which ? p.in[I_CV] : p.in[I_CK]) + i;
            const f32x4 a = *(const f32x4*)src, b2 = *(const f32x4*)(src + 4);
            u32x4 o; o.x = pk2(a.x, a.y); o.y = pk2(a.z, a.w); o.z = pk2(b2.x, b2.y); o.w = pk2(b2.z, b2.w);
            *(u32x4*)((which ? cvb : ckb) + i) = o;
        }
    }
    {
        bf16* DC = (bf16*)(ws + WS_DFTC); bf16* DL = (bf16*)(ws + WS_DFTL);
        const int total = 16384 + 1048576;
        for (int ch = bid * NTHR + tid; ch < total; ch += G * NTHR) {
            int L, e0; bf16* base; float sc;
            if (ch < 16384) { L = 256; base = DC; e0 = ch * 8; sc = 0.0625f; } else { L = 2048; base = DL; e0 = (ch - 16384) * 8; sc = 0.02209708691207961f; }
            const int rho = e0 / L, l0 = e0 % L, k = (rho >> 8) * 128 + (rho & 127), ty = (rho >> 7) & 1;
            float v[8];
#pragma unroll
            for (int e = 0; e < 8; ++e) { const int r = (k * (l0 + e)) & (L - 1); const float x = 2.0f * (float)r / (float)L; v[e] = (ty ? sinpif(x) : cospif(x)) * sc; }
            u32x4 o; o.x = pk2(v[0], v[1]); o.y = pk2(v[2], v[3]); o.z = pk2(v[4], v[5]); o.w = pk2(v[6], v[7]);
            *(u32x4*)(base + e0) = o;
        }
    }
}

template <int L>
__device__ __forceinline__ void taps_item(const Params& p, LAS unsigned char* lds, const int tid, int l, int o, int cgi) {
    constexpr bool HV = (L == 2048);
    constexpr int NC = HV ? 8 : 16, NCOLS = 2 * NC, TPT = HV ? 4 : 1, RS = 2 * L, Lp = 2 * L + 16, lk = HV ? 1 : 0;
    const int lane = tid & 63, wave = tid >> 6;
    LAS float* w3s = (LAS float*)lds; LAS float* red = (LAS float*)(lds + 8192); LAS float* tot = (LAS float*)(lds + 8192 + 512); LAS bf16* Rb = (LAS bf16*)(lds + 16384);
    const float* hid = (const float*)(p.ws + WS_HID) + (size_t)(l * 2 + lk) * 2048 * 64;
    __syncthreads();
    for (int i = tid; i < NCOLS * 64; i += NTHR) { const int lc = i >> 6, j = i & 63, dir = lc / NC, c = cgi * NC + lc % NC; w3s[i] = p.in[I_FW3][(size_t)(l * 64 + j) * 2048 + o * 1024 + dir * 512 + c]; }
    if (tid < NC) Rb[tid * RS] = 0;
    if (tid < 128) red[tid] = 0.f;
    __syncthreads();
    constexpr int NTW = HV ? 16 : 4;
    const int q = lane & 15, sgrp = lane >> 4;
    const int nt = HV ? 0 : (wave & 1), tile0 = HV ? wave * 16 : (wave >> 1) * 4;
    const int lc = nt * 16 + q, dir = lc / NC, ci = lc % NC, cch = cgi * NC + ci;
    float bfr[16];
#pragma unroll
    for (int kk = 0; kk < 16; ++kk) bfr[kk] = w3s[lc * 64 + 16 * sgrp + kk];
    f32x4 acc[NTW];
#pragma unroll
    for (int i = 0; i < NTW; ++i) {
        const int t0 = (tile0 + i) * 16;
        const f32x4* hr = (const f32x4*)(hid + (size_t)(t0 + q) * 64 + 16 * sgrp);
        const f32x4 h0 = hr[0], h1 = hr[1], h2 = hr[2], h3 = hr[3];
        f32x4 a = (f32x4){0.f, 0.f, 0.f, 0.f};
        a = __builtin_amdgcn_mfma_f32_16x16x4f32(h0.x, bfr[0], a, 0, 0, 0); a = __builtin_amdgcn_mfma_f32_16x16x4f32(h0.y, bfr[1], a, 0, 0, 0);
        a = __builtin_amdgcn_mfma_f32_16x16x4f32(h0.z, bfr[2], a, 0, 0, 0); a = __builtin_amdgcn_mfma_f32_16x16x4f32(h0.w, bfr[3], a, 0, 0, 0);
        a = __builtin_amdgcn_mfma_f32_16x16x4f32(h1.x, bfr[4], a, 0, 0, 0); a = __builtin_amdgcn_mfma_f32_16x16x4f32(h1.y, bfr[5], a, 0, 0, 0);
        a = __builtin_amdgcn_mfma_f32_16x16x4f32(h1.z, bfr[6], a, 0, 0, 0); a = __builtin_amdgcn_mfma_f32_16x16x4f32(h1.w, bfr[7], a, 0, 0, 0);
        a = __builtin_amdgcn_mfma_f32_16x16x4f32(h2.x, bfr[8], a, 0, 0, 0); a = __builtin_amdgcn_mfma_f32_16x16x4f32(h2.y, bfr[9], a, 0, 0, 0);
        a = __builtin_amdgcn_mfma_f32_16x16x4f32(h2.z, bfr[10], a, 0, 0, 0); a = __builtin_amdgcn_mfma_f32_16x16x4f32(h2.w, bfr[11], a, 0, 0, 0);
        a = __builtin_amdgcn_mfma_f32_16x16x4f32(h3.x, bfr[12], a, 0, 0, 0); a = __builtin_amdgcn_mfma_f32_16x16x4f32(h3.y, bfr[13], a, 0, 0, 0);
        a = __builtin_amdgcn_mfma_f32_16x16x4f32(h3.z, bfr[14], a, 0, 0, 0); a = __builtin_amdgcn_mfma_f32_16x16x4f32(h3.w, bfr[15], a, 0, 0, 0);
        acc[i] = a;
    }
    const float delta = fabsf(MIN_DECAY + (float)cch * ((MAX_DECAY - MIN_DECAY) / 511.0f));
    float asum = 0.f;
#pragma unroll
    for (int i = 0; i < NTW; ++i)
#pragma unroll
        for (int e2 = 0; e2 < 4; ++e2) { const int t = (tile0 + i) * 16 + 4 * sgrp + e2; const float v = acc[i][e2] * __expf(-((float)t * (1.0f / (float)(L - 1))) * delta); acc[i][e2] = v; asum += fabsf(v); }
    asum += __shfl_xor(asum, 16); asum += __shfl_xor(asum, 32);
    if (lane < 16) red[wave * 16 + lane] = asum;
    __syncthreads();
    if (tid < NCOLS) { float s2 = 0.f;
        if (HV) {
#pragma unroll
            for (int w = 0; w < 8; ++w) s2 += red[w * 16 + tid]; }
        else {
#pragma unroll
            for (int w = 0; w < 4; ++w) s2 += red[(2 * w + (tid >> 4)) * 16 + (tid & 15)]; }
        tot[tid] = 1.0f / (s2 + EPS); }
    __syncthreads();
    const float inv = tot[lc];
#pragma unroll
    for (int i = 0; i < NTW; ++i)
#pragma unroll
        for (int e2 = 0; e2 < 4; ++e2) { const int t = (tile0 + i) * 16 + 4 * sgrp + e2; const int x = dir ? L + t : L - t;
            if (!(dir && t == 0)) Rb[ci * RS + x] = (bf16)f2bf(acc[i][e2] * inv); }
    __syncthreads();
    constexpr int nchunk = (2 * L) / 8;
    bf16* dst = (bf16*)(p.ws + WS_KF) + (size_t)l * KF_LAYER + (lk ? KF_LK0 : 0) + (size_t)(o * 512 + cgi * NC) * Lp;
    for (int i = tid; i < NC * nchunk; i += NTHR) {
        const int cc = i / nchunk, y0 = (i % nchunk) * 8;
        *(u32x4*)(dst + (size_t)cc * Lp + y0) = *(const LAS u32x4*)(Rb + cc * RS + y0);
    }
}
__device__ __forceinline__ void taps_any(const Params& p, LAS unsigned char* lds, const int tid, int l, int j) {
    if (j < 128) taps_item<2048>(p, lds, tid, l, j >> 6, j & 63);
    else { const int r = j - 128; taps_item<256>(p, lds, tid, l, r >> 5, r & 31); }
}
__device__ __forceinline__ void phase_taps(const Params& p, LAS unsigned char* lds) {
    for (int it = blockIdx.x; it < 384; it += gridDim.x) {
        int tid = threadIdx.x; asm volatile("" : "+v"(tid));
        taps_any(p, lds, tid, it & 1, it >> 1);
    }
    __syncthreads();
}

__device__ __forceinline__ void phase_norm(const Params& p, int l) {
    int tid_o = threadIdx.x; asm volatile("" : "+v"(tid_o));
    const int tid = tid_o, lane = tid & 63, wave = tid >> 6;
    const int gw = blockIdx.x * NWAVES + wave, NGW = gridDim.x * NWAVES;
    bf16* H = (bf16*)(p.ws + WS_H);
    const float* ada = (const float*)(p.ws + WS_ADA);
    for (int row = gw; row < MTOK; row += NGW) {
        const float* x = (l == 0) ? (row < NCTX ? p.in[I_XP] + (size_t)row * DM : p.in[I_XS] + (size_t)(row - NCTX) * DM) : p.out + (size_t)row * DM;
        const int cv = row < NCTX ? 0 : 1 + ((row - NCTX) >> 11);
        f32x4 v[8]; float ss = 0.f;
#pragma unroll
        for (int j = 0; j < 8; ++j) { v[j] = ((const f32x4*)x)[lane + 64 * j]; ss += v[j].x * v[j].x + v[j].y * v[j].y + v[j].z * v[j].z + v[j].w * v[j].w; }
        ss = wave_sum(ss);
        const float rs = rsqrtf(ss * (1.0f / 2048.0f) + EPS);
        const float* ad = ada + (l * 3 + cv) * 6144;
        const float* ng = p.in[I_NG] + l * 2048;
#pragma unroll
        for (int j = 0; j < 8; ++j) {
            const int idx = (lane + 64 * j) * 4;
            const f32x4 g4 = *(const f32x4*)(ng + idx), sh = *(const f32x4*)(ad + idx), sc = *(const f32x4*)(ad + 2048 + idx);
            const f32x4 h = v[j] * rs * g4 * (sc + 1.0f) + sh;
            u32x2 w; w.x = pk2(h.x, h.y); w.y = pk2(h.z, h.w);
            *(u32x2*)(H + (size_t)row * DM + idx) = w;
        }
    }
}

constexpr int AT_KS = 0, AT_VT = 17408, AT_BUF = 36864;
__device__ __forceinline__ void attn_unit(const Params& p, LAS unsigned char* lds, const int tid, int kind, int b, int h, int sub, int layer) {
    const int lane = tid & 63, wave = tid >> 6, q16 = lane & 15, g = lane >> 4;
    const bf16* P = (const bf16*)(p.ws + WS_P);
    bf16* Y = (bf16*)(p.ws + WS_YMIX);
    LAS float* rpbL = (LAS float*)(lds + 2 * AT_BUF);
    const float* qg = p.in[I_QG] + layer * 128; const float* kg = p.in[I_KG] + layer * 128;
    int tokq, r = 0, qc = 0, cs = 0, rs_ = 0;
    if (kind == 0) tokq = b * 256 + sub * 128 + wave * 16 + q16;
    else { r = 2 * sub + (wave >> 2); qc = (wave & 3) * 16 + q16; tokq = NCTX + b * 2048 + r * 64 + qc; cs = min(max(qc - 8, 0), 48); rs_ = min(max(r - 4, 0), 24); }
    int kr0 = 0, nwin = 0;
    if (kind == 1) { const int r0 = 2 * sub; kr0 = min(max(r0 - 4, 0), 24); const int kr1 = min(max(r0 + 1 - 4, 0), 24) + 7; nwin = kr1 - kr0 + 1; }
    const int nchunks = kind == 0 ? 4 : nwin + 8;
    u32x4 kA0, kA1, vA0, vA1, kB0, kB1, vB0, vB1;
    const int kkey = tid >> 3, kd = (tid & 7) * 16, vkey = lane, vd = wave * 16;
    float kgv[16];
#pragma unroll
    for (int j = 0; j < 4; ++j) { const f32x4 g4 = *(const f32x4*)(kg + kd + 4 * j); kgv[4 * j] = g4.x; kgv[4 * j + 1] = g4.y; kgv[4 * j + 2] = g4.z; kgv[4 * j + 3] = g4.w; }
    const bf16* CKB = (const bf16*)(p.ws + WS_CKB); const bf16* CVB = (const bf16*)(p.ws + WS_CVB);
#define AT_LOAD(ci, K0, K1, V0, V1) do { if ((ci) < nchunks) { \
        const bf16* pk; const bf16* pv; \
        if (kind == 1 && (ci) >= nwin) { \
            const int cc = (ci) - nwin; \
            pk = CKB + ((size_t)((b * 2 + layer) * 512 + cc * 64 + kkey) * 8 + h) * 128 + kd; \
            pv = CVB + ((size_t)((b * 2 + layer) * 512 + cc * 64 + vkey) * 8 + h) * 128 + vd; \
        } else { \
            const int tk0 = kind == 0 ? b * 256 + (ci) * 64 : NCTX + b * 2048 + (kr0 + (ci)) * 64; \
            pk = P + (size_t)(tk0 + kkey) * NIN + OFF_K + h * 128 + kd; \
            pv = P + (size_t)(tk0 + vkey) * NIN + OFF_V + h * 128 + vd; \
        } \
        K0 = *(const u32x4*)pk; K1 = *(const u32x4*)(pk + 8); V0 = *(const u32x4*)pv; V1 = *(const u32x4*)(pv + 8); } } while (0)
#define AT_CHUNK(ci, K0, K1, V0, V1) do { \
        const bool cached = (kind == 1 && (ci) >= nwin); \
        LAS bf16* Ks = (LAS bf16*)(lds + ((ci) & 1) * AT_BUF + AT_KS); LAS bf16* Vt = (LAS bf16*)(lds + ((ci) & 1) * AT_BUF + AT_VT);     \
        { \
            float kv[16]; \
            unpack8(K0, kv); unpack8(K1, kv + 8); \
            u32x4 w0 = K0, w1 = K1; \
            if (!cached) { \
                float ss = 0.f; \
                _Pragma("unroll") for (int e = 0; e < 16; ++e) ss += kv[e] * kv[e]; \
                ss += __shfl_xor(ss, 1); ss += __shfl_xor(ss, 2); ss += __shfl_xor(ss, 4); \
                const float rk = rsqrtf(ss * (1.0f / 128.0f) + EPS); \
                _Pragma("unroll") for (int e = 0; e < 16; ++e) kv[e] = kv[e] * rk * kgv[e]; \
                if (kind == 0 && sub == 0) { \
                    float* nk = p.out + (size_t)MTOK * DM + ((size_t)((b * 2 + layer) * 256 + (ci) * 64 + kkey) * 8 + h) * 128 + kd; \
                    _Pragma("unroll") for (int j = 0; j < 4; ++j) *(f32x4*)(nk + 4 * j) = (f32x4){kv[4 * j], kv[4 * j + 1], kv[4 * j + 2], kv[4 * j + 3]}; \
                } \
                w0.x = pk2(kv[0], kv[1]); w0.y = pk2(kv[2], kv[3]); w0.z = pk2(kv[4], kv[5]); w0.w = pk2(kv[6], kv[7]); \
                w1.x = pk2(kv[8], kv[9]); w1.y = pk2(kv[10], kv[11]); w1.z = pk2(kv[12], kv[13]); w1.w = pk2(kv[14], kv[15]); \
            } \
            *(LAS u32x4*)(Ks + kkey * 136 + kd) = w0; *(LAS u32x4*)(Ks + kkey * 136 + kd + 8) = w1; \
            { const unsigned vw[8] = {V0.x, V0.y, V0.z, V0.w, V1.x, V1.y, V1.z, V1.w}; \
              _Pragma("unroll") for (int j = 0; j < 8; ++j) { Vt[(vd + 2 * j) * 72 + vkey] = (bf16)(vw[j] & 0xffffu); Vt[(vd + 2 * j + 1) * 72 + vkey] = (bf16)(vw[j] >> 16); } } \
        } \
        __syncthreads(); \
        AT_LOAD((ci) + 2, K0, K1, V0, V1); \
        const int kr = kr0 + (ci); \
        const bool win = (kind == 1 && !cached); \
        if (!(win && (kr < rs_ || kr >= rs_ + 8))) {     \
        f32x4 st[4]; \
        _Pragma("unroll") for (int kt = 0; kt < 4; ++kt) { st[kt] = (f32x4){0.f, 0.f, 0.f, 0.f}; \
            _Pragma("unroll") for (int ks = 0; ks < 4; ++ks) { const bf16x8 a = *(const LAS bf16x8*)(Ks + (16 * kt + q16) * 136 + 32 * ks + 8 * g); \
                st[kt] = __builtin_amdgcn_mfma_f32_16x16x32_bf16(a, qf[ks], st[kt], 0, 0, 0); } } \
        if (win) { \
            const LAS float* br = rpbL + (kr - r + 7) * 31 + (15 - qc); \
            _Pragma("unroll") for (int kt = 0; kt < 4; ++kt) \
                _Pragma("unroll") for (int e = 0; e < 4; ++e) { const int kc = 16 * kt + 4 * g + e; const bool ok = (kc >= cs) && (kc < cs + 16); \
                    const float bias = ok ? br[kc] : 0.f; st[kt][e] = ok ? st[kt][e] + bias : -1e30f; } \
        } \
        float mx = -1e30f; \
        _Pragma("unroll") for (int kt = 0; kt < 4; ++kt) \
            _Pragma("unroll") for (int e = 0; e < 4; ++e) mx = fmaxf(mx, st[kt][e]); \
        mx = fmaxf(mx, __shfl_xor(mx, 16)); mx = fmaxf(mx, __shfl_xor(mx, 32)); \
        const float m_new = fmaxf(m_run, mx); \
        const float alpha = __builtin_amdgcn_exp2f(m_run - m_new); \
        m_run = m_new; \
        float ps = 0.f; \
        _Pragma("unroll") for (int kt = 0; kt < 4; ++kt) \
            _Pragma("unroll") for (int e = 0; e < 4; ++e) { const float pe = __builtin_amdgcn_exp2f(st[kt][e] - m_new); st[kt][e] = pe; ps += pe; } \
        lsum = lsum * alpha + ps; \
        _Pragma("unroll") for (int dt = 0; dt < 8; ++dt) o[dt] = o[dt] * alpha; \
        bf16x8 pb[2]; \
        _Pragma("unroll") for (int pr = 0; pr < 2; ++pr) { u32x4 w; w.x = pk2(st[2 * pr][0], st[2 * pr][1]); w.y = pk2(st[2 * pr][2], st[2 * pr][3]); w.z = pk2(st[2 * pr + 1][0], st[2 * pr + 1][1]); w.w = pk2(st[2 * pr + 1][2], st[2 * pr + 1][3]); \
            pb[pr] = __builtin_bit_cast(bf16x8, w); } \
        _Pragma("unroll") for (int dt = 0; dt < 8; ++dt) \
            _Pragma("unroll") for (int pr = 0; pr < 2; ++pr) { \
                const LAS bf16* vp = Vt + (16 * dt + q16) * 72 + 32 * pr + 4 * g; \
                const u32x2 lo = *(const LAS u32x2*)vp, hi = *(const LAS u32x2*)(vp + 16); \
                u32x4 w; w.x = lo.x; w.y = lo.y; w.z = hi.x; w.w = hi.y; \
                o[dt] = __builtin_amdgcn_mfma_f32_16x16x32_bf16(__builtin_bit_cast(bf16x8, w), pb[pr], o[dt], 0, 0, 0); \
            } \
        } } while (0)
    AT_LOAD(0, kA0, kA1, vA0, vA1);
    AT_LOAD(1, kB0, kB1, vB0, vB1);
    u32x2 gaw[8];
    { const bf16* gap = P + (size_t)tokq * NIN + OFF_GA + h * 128;
#pragma unroll
      for (int dt = 0; dt < 8; ++dt) gaw[dt] = *(const u32x2*)(gap + 16 * dt + 4 * g); }
    bf16x8 qf[4];
    {
        float qv[4][8]; float ss = 0.f;
#pragma unroll
        for (int ks = 0; ks < 4; ++ks) { const u32x4 w = *(const u32x4*)(P + (size_t)tokq * NIN + OFF_Q + h * 128 + 32 * ks + 8 * g); unpack8(w, qv[ks]);
#pragma unroll
            for (int e = 0; e < 8; ++e) ss += qv[ks][e] * qv[ks][e]; }
        ss += __shfl_xor(ss, 16); ss += __shfl_xor(ss, 32);
        const float rq = rsqrtf(ss * (1.0f / 128.0f) + EPS) * (0.08838834764831845f * 1.4426950408889634f);
#pragma unroll
        for (int ks = 0; ks < 4; ++ks) { float t[8];
#pragma unroll
            for (int e = 0; e < 8; ++e) t[e] = qv[ks][e] * rq * qg[32 * ks + 8 * g + e];
            u32x4 w; w.x = pk2(t[0], t[1]); w.y = pk2(t[2], t[3]); w.z = pk2(t[4], t[5]); w.w = pk2(t[6], t[7]);
            qf[ks] = __builtin_bit_cast(bf16x8, w); }
    }
    __syncthreads();
    if (kind == 1) { for (int i = tid; i < 465; i += NTHR) rpbL[i] = p.in[I_RPB][(size_t)(layer * 8 + h) * 465 + i] * 1.4426950408889634f; }
    float m_run = -1e30f, lsum = 0.f;
    f32x4 o[8];
#pragma unroll
    for (int dt = 0; dt < 8; ++dt) o[dt] = (f32x4){0.f, 0.f, 0.f, 0.f};
#pragma unroll 1
    for (int ci = 0; ci < nchunks; ci += 2) {
        AT_CHUNK(ci, kA0, kA1, vA0, vA1);
        if (ci + 1 < nchunks) AT_CHUNK(ci + 1, kB0, kB1, vB0, vB1);
    }
#undef AT_LOAD
#undef AT_CHUNK
    lsum += __shfl_xor(lsum, 16); lsum += __shfl_xor(lsum, 32);
    const float inv = 1.0f / lsum;
    bf16* yp = Y + (size_t)tokq * DM + h * 128;
#pragma unroll
    for (int dt = 0; dt < 8; ++dt) {
        const int d0 = 16 * dt + 4 * g;
        const u32x2 gw = gaw[dt];
        const float g0 = bf2f(gw.x & 0xffffu), g1 = bf2f(gw.x >> 16), g2 = bf2f(gw.y & 0xffffu), g3 = bf2f(gw.y >> 16);
        u32x2 w; w.x = pk2(o[dt][0] * inv * siluf_(g0), o[dt][1] * inv * siluf_(g1)); w.y = pk2(o[dt][2] * inv * siluf_(g2), o[dt][3] * inv * siluf_(g3));
        *(u32x2*)(yp + d0) = w;
    }
}

template <int L, int NB>
__device__ __forceinline__ void hyena_unit(const Params& p, LAS unsigned char* lds, const int tid, int c, int layer) {
    constexpr int NT = L * NB, PER = NT / NTHR, LAT = (L == 2048);
    LAS float* zb = (LAS float*)lds; LAS float* x1b = zb + NT; LAS float* x2b = x1b + NT; LAS float* tf = x2b + NT;
    const bf16* HT = (const bf16*)(p.ws + WS_HT) + (LAT ? (size_t)32 * 2048 * 256 : 0);
    const bf16* KF = (const bf16*)(p.ws + WS_KF) + (size_t)layer * KF_LAYER + (LAT ? KF_LK0 : 0);
    bf16* Y = (bf16*)(p.ws + WS_YMIX);
    constexpr int Lp = 2 * L + 16;
    const float* cw = p.in[I_CW] + (size_t)layer * 3 * 1536; const float* cb = p.in[I_CB] + layer * 1536;
    __syncthreads();
    for (int j = 0; j < 3; ++j) {
        const float w0 = cw[0 * 1536 + j * 512 + c], w1 = cw[1 * 1536 + j * 512 + c], w2 = cw[2 * 1536 + j * 512 + c], bb = cb[j * 512 + c];
        LAS float* dst = j == 0 ? zb : (j == 1 ? x1b : x2b);
        for (int idx = tid; idx < NT; idx += NTHR) {
            const int bat = idx / L, t = idx % L;
            const bf16* row = HT + ((size_t)bat * 2048 + j * 512 + c) * L;
            const float xm = t > 0 ? bf2f(row[t - 1]) : 0.f, x0 = bf2f(row[t]), xp = t < L - 1 ? bf2f(row[t + 1]) : 0.f;
            dst[idx] = xm * w0 + x0 * w1 + xp * w2 + bb;
        }
    }
    for (int o = 0; o < 2; ++o) {
        __syncthreads();
        const bf16* kf = KF + (size_t)((o * 512 + c) * 8) * Lp;
        for (int x = tid; x < 2 * L; x += NTHR) tf[x] = bf2f(kf[x]);
        __syncthreads();
        const LAS float* zin = o == 0 ? zb : x1b;
        const float hb = p.in[I_HYB][(layer * 2 + o) * 512 + c];
        float acc[PER];
#pragma unroll
        for (int j = 0; j < PER; ++j) acc[j] = 0.f;
        if constexpr (LAT) {
#pragma unroll 2
            for (int s = 0; s < L; ++s) {
                const float z0 = zin[s], z1 = zin[L + s];
#pragma unroll
                for (int j = 0; j < 4; ++j) { const float tp = tf[L - (tid + 512 * j) + s]; acc[j] += tp * z0; acc[4 + j] += tp * z1; }
            }
        } else {
            const int t = tid & 255, b0 = tid >> 8;
#pragma unroll 2
            for (int s = 0; s < L; ++s) {
                const float tp = tf[L - t + s];
#pragma unroll
                for (int j = 0; j < PER; ++j) acc[j] += tp * zin[(b0 + 2 * j) * L + s];
            }
        }
        __syncthreads();
#pragma unroll
        for (int j = 0; j < PER; ++j) {
            int bat, t;
            if constexpr (LAT) { bat = j >> 2; t = tid + 512 * (j & 3); } else { bat = (tid >> 8) + 2 * j; t = tid & 255; }
            const int idx = bat * L + t;
            if (o == 0) { x1b[idx] = x1b[idx] * (acc[j] + hb * zb[idx]); }
            else {
                const float zz = x2b[idx] * (acc[j] + hb * x1b[idx]);
                const float gc = bf2f(HT[((size_t)bat * 2048 + 1536 + c) * L + t]);
                const size_t tok = LAT ? (size_t)(NCTX + bat * 2048 + t) : (size_t)(bat * 256 + t);
                Y[tok * DM + 1536 + c] = (bf16)f2bf(zz * siluf_(gc));
            }
        }
    }
}

#ifndef PROBE
#define PROBE 0
#endif
#define REPM(k) _Pragma("unroll 1") for (int rm_ = 0; rm_ < ((PROBE == (k)) ? 2 : 1); ++rm_)
template <int L, int NB>
__device__ __forceinline__ void hyena_mfma_unit(const Params& p, LAS unsigned char* lds, const int tid, int unit, int layer) {
    constexpr bool LAT = (L == 2048);
    constexpr int NBLK = L / 64, NCOL = NB * NBLK, Lp = 2 * L + 16, MTW = LAT ? 2 : 4;
    constexpr int TC_BYTES = 8 * Lp * 2, Z_OFF = TC_BYTES, Z_BYTES = NCOL * 72 * 2, X1_OFF = Z_OFF + Z_BYTES, X_BYTES = NCOL * 68 * 4, X2_OFF = X1_OFF + X_BYTES;
    constexpr int CH = LAT ? 4 : 2;
    constexpr int OUT_OFF = X2_OFF + X_BYTES, OUT_BYTES = NB * L * CH * 2;
    static_assert(OUT_OFF + OUT_BYTES <= LDS_WORD_OFF, "hyena LDS");
    const int lane = tid & 63, wave = tid >> 6, q = lane & 15, g = lane >> 4;
    LAS bf16* OB = (LAS bf16*)(lds + OUT_OFF);
    LAS bf16* Tc = (LAS bf16*)lds; LAS bf16* Z = (LAS bf16*)(lds + Z_OFF); LAS float* X1 = (LAS float*)(lds + X1_OFF); LAS float* X2 = (LAS float*)(lds + X2_OFF);
    const bf16* HT = (const bf16*)(p.ws + WS_HT) + (LAT ? (size_t)32 * 2048 * 256 : 0);
    const bf16* KF = (const bf16*)(p.ws + WS_KF) + (size_t)layer * KF_LAYER + (LAT ? KF_LK0 : 0);
    bf16* Y = (bf16*)(p.ws + WS_YMIX);
    const float* cw = p.in[I_CW] + (size_t)layer * 3 * 1536; const float* cb = p.in[I_CB] + layer * 1536;
    const int nt = LAT ? (wave & 3) : wave, mt0 = LAT ? 2 * (wave >> 2) : 0;
    const int n = 16 * nt + q, I = n & (NBLK - 1), bat = n / NBLK;
#pragma unroll 1
    for (int cc = 0; cc < CH; ++cc) {
    const int c = unit * CH + cc;
    u32x4 tp0 = (u32x4){0u, 0u, 0u, 0u}, tp1 = (u32x4){0u, 0u, 0u, 0u};
    if (tid < (2 * L) / 8) { tp0 = ((const u32x4*)(KF + (size_t)(0 * 512 + c) * Lp))[tid]; tp1 = ((const u32x4*)(KF + (size_t)(1 * 512 + c) * Lp))[tid]; }
    u32x2 gcw[MTW];
#pragma unroll
    for (int mi = 0; mi < MTW; ++mi) gcw[mi] = *(const u32x2*)(HT + ((size_t)bat * 2048 + 1536 + c) * L + 64 * I + 16 * (mt0 + mi) + 4 * g);
    __syncthreads();
    REPM(20)
#pragma unroll
    for (int it = 0; it < NB * L / 8 / NTHR; ++it) {
        const int idx8 = tid + NTHR * it, bat = idx8 / (L / 8), t0 = (idx8 % (L / 8)) * 8, n = bat * NBLK + (t0 >> 6), i0 = t0 & 63;
#pragma unroll
        for (int j = 0; j < 3; ++j) {
            const bf16* row = HT + ((size_t)bat * 2048 + j * 512 + c) * L;
            const u32x4 w = *(const u32x4*)(row + t0);
            float x[10]; x[0] = t0 > 0 ? bf2f(row[t0 - 1]) : 0.f; unpack8(w, x + 1); x[9] = (t0 + 8 < L) ? bf2f(row[t0 + 8]) : 0.f;
            const float w0 = cw[0 * 1536 + j * 512 + c], w1 = cw[1 * 1536 + j * 512 + c], w2 = cw[2 * 1536 + j * 512 + c], bb = cb[j * 512 + c];
            float y[8];
#pragma unroll
            for (int e = 0; e < 8; ++e) y[e] = x[e] * w0 + x[e + 1] * w1 + x[e + 2] * w2 + bb;
            if (j == 0) { u32x4 o; o.x = pk2(y[0], y[1]); o.y = pk2(y[2], y[3]); o.z = pk2(y[4], y[5]); o.w = pk2(y[6], y[7]); *(LAS u32x4*)(Z + n * 72 + i0) = o; }
            else { LAS float* X = (j == 1 ? X1 : X2) + n * 68 + i0; *(LAS f32x4*)X = (f32x4){y[0], y[1], y[2], y[3]}; *(LAS f32x4*)(X + 4) = (f32x4){y[4], y[5], y[6], y[7]}; }
        }
    }
    const int dlo = LAT ? ((nt & 1) * 16 - 31) : -3, dhi = LAT ? ((nt & 1) * 16 + 15) : 3;
#pragma unroll 1
    for (int o = 0; o < 2; ++o) {
        __syncthreads();
        REPM(21) { __syncthreads();
            if (tid < (2 * L) / 8) ((LAS u32x4*)Tc)[tid] = (o == 0) ? tp0 : tp1;
            __syncthreads();
            const LAS unsigned* D = (const LAS unsigned*)Tc;
            constexpr int NCH = (2 * L) / 8;
            for (int i = tid; i < 7 * NCH; i += NTHR) {
                const int sg = 1 + i / NCH, w0 = (i % NCH) * 4;
                const int a = w0 - ((sg + 1) >> 1);
                unsigned d[5];
#pragma unroll
                for (int k = 0; k < 5; ++k) d[k] = D[max(a + k, 0)];
                u32x4 w;
                if (sg & 1) { w.x = __builtin_amdgcn_alignbit(d[1], d[0], 16); w.y = __builtin_amdgcn_alignbit(d[2], d[1], 16); w.z = __builtin_amdgcn_alignbit(d[3], d[2], 16); w.w = __builtin_amdgcn_alignbit(d[4], d[3], 16); }
                else { w.x = d[0]; w.y = d[1]; w.z = d[2]; w.w = d[3]; }
                *(LAS u32x4*)(Tc + sg * Lp + w0 * 2) = w;
            }
        }
        __syncthreads();
        f32x4 acc[MTW];
#pragma unroll
        for (int mi = 0; mi < MTW; ++mi) acc[mi] = (f32x4){0.f, 0.f, 0.f, 0.f};
        const LAS bf16* tcl = Tc + (q & 7) * Lp + 8 * g + L - (q & 8);
        REPM(22)
#pragma unroll 2
        for (int d = dlo; d <= dhi; ++d) {
            const int J = I - d; const bool valid = (J >= 0) && (J < NBLK);
            const LAS bf16* zp = Z + (valid ? (n - d) : n) * 72 + 8 * g;
#pragma unroll
            for (int jh = 0; jh < 2; ++jh) {
                bf16x8 B = *(const LAS bf16x8*)(zp + 32 * jh);
                if (!valid) B = (bf16x8){0, 0, 0, 0, 0, 0, 0, 0};
#pragma unroll
                for (int mi = 0; mi < MTW; ++mi) {
                    const bf16x8 A = *(const LAS bf16x8*)(tcl + 32 * jh - 16 * (mt0 + mi) - 64 * d);
                    acc[mi] = __builtin_amdgcn_mfma_f32_16x16x32_bf16(A, B, acc[mi], 0, 0, 0);
                }
            }
        }
        __syncthreads();
        const float hb = p.in[I_HYB][(layer * 2 + o) * 512 + c];
#pragma unroll
        for (int mi = 0; mi < MTW; ++mi) {
            const int i = 16 * (mt0 + mi) + 4 * g;
            const u32x2 zw = *(const LAS u32x2*)(Z + n * 72 + i);
            const float z0 = bf2f(zw.x & 0xffffu), z1 = bf2f(zw.x >> 16), z2 = bf2f(zw.y & 0xffffu), z3 = bf2f(zw.y >> 16);
            const f32x4 xv = *(const LAS f32x4*)((o == 0 ? X1 : X2) + n * 68 + i);
            const float r0 = xv.x * (acc[mi][0] + hb * z0), r1 = xv.y * (acc[mi][1] + hb * z1), r2 = xv.z * (acc[mi][2] + hb * z2), r3 = xv.w * (acc[mi][3] + hb * z3);
            if (o == 0) { u32x2 w; w.x = pk2(r0, r1); w.y = pk2(r2, r3); *(LAS u32x2*)(Z + n * 72 + i) = w; }
            else {
                const int t = 64 * I + i;
                const u32x2 gw = gcw[mi];
                LAS bf16* ob = OB + (bat * L + t) * CH + cc;
                ob[0] = (bf16)f2bf(r0 * siluf_(bf2f(gw.x & 0xffffu))); ob[CH] = (bf16)f2bf(r1 * siluf_(bf2f(gw.x >> 16)));
                ob[2 * CH] = (bf16)f2bf(r2 * siluf_(bf2f(gw.y & 0xffffu))); ob[3 * CH] = (bf16)f2bf(r3 * siluf_(bf2f(gw.y >> 16)));
            }
        }
    }
    }
    __syncthreads();
    for (int idx = tid; idx < NB * L; idx += NTHR) {
        const int bt = idx / L, t = idx % L;
        const size_t tok = LAT ? (size_t)(NCTX + bt * 2048 + t) : (size_t)(bt * 256 + t);
        bf16* yp = Y + tok * DM + 1536 + unit * CH;
        if (CH == 4) *(u32x2*)yp = *(const LAS u32x2*)(OB + idx * CH); else if (CH == 2) *(unsigned*)yp = *(const LAS unsigned*)(OB + idx * CH); else *yp = OB[idx];
    }
}

constexpr int Q_FL = 64, Q_HL = 128, Q_AL = 256, Q_HC = 256, Q_AC = 512, Q_FC = 128;
constexpr int Q_TOTAL = Q_FL + Q_HL + Q_AL + Q_HC + Q_AC + Q_FC;
constexpr int PREP_TR = TR_LAYER / 32, PREP_TOTAL = 96 + 128 + PREP_TR + 192;
static_assert(TR_LAYER % 32 == 0, "prep");
__device__ __forceinline__ void phase_mix(const Params& p, LAS unsigned char* lds, int layer, int pass) {
    volatile LAS int* qw = (volatile LAS int*)(lds + LDS_WORD_OFF);
    unsigned* ctr = (unsigned*)(p.ws + WS_CTL) + 64 * (layer * 2 + pass);
    const bf16* P = (const bf16*)(p.ws + WS_P);
    bf16* Y = (bf16*)(p.ws + WS_YMIX);
    unsigned* pctr = (unsigned*)(p.ws + WS_CTL) + 64 * 8;
    bool main_left = true, prep_left = false;
    for (;;) {
        int tid = threadIdx.x; asm volatile("" : "+v"(tid));
        if (prep_left) {
            __syncthreads();
            if (tid == 0) qw[0] = (int)atomicAdd(pctr, 1u);
            __syncthreads();
            const int pid = qw[0];
            if (pid >= PREP_TOTAL) prep_left = false;
            else if (pid < 96) ada_item(p, lds, tid, 96 + pid);
            else if (pid < 224) fold_item(p, lds, tid, 128 + (pid - 96));
            else if (pid < 224 + PREP_TR) { __syncthreads(); const int base = TR_LAYER + 32 * (pid - 224) + 4 * (tid >> 6);
                for (int k = 0; k < 4; ++k) transpose_witem(p, (LAS float*)(lds + (tid >> 6) * 16384), tid & 63, base + k); }
            else taps_any(p, lds, tid, 1, pid - 224 - PREP_TR);
        }
        if (!main_left) { if (!prep_left) break; continue; }
        __syncthreads();
        if (tid == 0) qw[0] = (int)atomicAdd(ctr, 1u);
        __syncthreads();
        int id = qw[0];
        if (id >= Q_TOTAL) { main_left = false; if (!prep_left) break; continue; }
        if (id < Q_FL) {
            pg8::Gemm g{(const pg8::bf16_t*)(p.ws + WS_DFTL), (const pg8::bf16_t*)(p.ws + WS_ZT) + (size_t)32 * 512 * 256, 4096, 1024, 2048};
            pg8::OneUnit S; S.u.pm = id >> 2; S.u.pn = id & 3; S.u.kind = 0;
            EpiF E{P, Y, 1};
            REPM(12) pg8::gemm_phase<EpiF, pg8::OneUnit, false, true>(lds, g, S, E);
            continue;
        }
        id -= Q_FL;
        if (id < Q_HL) { REPM(8) hyena_mfma_unit<2048, 2>(p, lds, tid, id, layer); continue; }
        id -= Q_HL;
        if (id < Q_AL) { REPM(10) attn_unit(p, lds, tid, 1, id >> 7, (id >> 4) & 7, id & 15, layer); continue; }
        id -= Q_AL;
        if (id < Q_HC) { REPM(9) hyena_mfma_unit<256, 32>(p, lds, tid, id, layer); continue; }
        id -= Q_HC;
        if (id < Q_AC) { REPM(11) attn_unit(p, lds, tid, 0, id >> 4, (id >> 1) & 7, id & 1, layer); continue; }
        id -= Q_AC;
        {
            pg8::Gemm g{(const pg8::bf16_t*)(p.ws + WS_DFTC), (const pg8::bf16_t*)(p.ws + WS_ZT), 512, 32 * 512, 256};
            pg8::OneUnit S; S.u.pm = id >> 6; S.u.pn = id & 63; S.u.kind = 0;
            EpiF E{P, Y, 0};
            REPM(12) pg8::gemm_phase<EpiF, pg8::OneUnit, false, true>(lds, g, S, E);
        }
    }
}

#define RLX_AGENT __ATOMIC_RELAXED, __HIP_MEMORY_SCOPE_AGENT
#define XB_TMO      128
#define XB_XCNT(j)  (256  + 64 * (j))
#define XB_XSUB(j)  (1280 + 64 * (j))
#define XB_XGEN(j)  (2304 + 64 * (j))
#define XB_TOP      3328
#define XB_TOPGEN   3392
#define XCD_BAR_WORDS 3456
#define XB_SPIN_CAP (1u << 18)

__device__ __forceinline__ unsigned xb_ld(unsigned* p)              { return __hip_atomic_load(p, __ATOMIC_RELAXED, __HIP_MEMORY_SCOPE_AGENT); }
__device__ __forceinline__ unsigned xb_add(unsigned* p, unsigned v) { return __hip_atomic_fetch_add(p, v, __ATOMIC_RELAXED, __HIP_MEMORY_SCOPE_AGENT); }
__device__ __forceinline__ unsigned xb_xcc_id() { return (unsigned)__builtin_amdgcn_s_getreg((3 << 11) | 20) & 0xFu; }
#define XB_SPIN(cond, bar) do { unsigned _sp = 0; while (cond) { __builtin_amdgcn_s_sleep(1); \
    if ((++_sp & 255u) == 0u) { if (xb_ld(&(bar)[XB_TMO])) break; if (_sp > XB_SPIN_CAP) { atomicAdd(&(bar)[XB_TMO], 1u); break; } } } } while (0)

struct XcdBarrier {
    unsigned* bar; unsigned x;
    volatile LAS unsigned* st;
};

__device__ __forceinline__ XcdBarrier xcd_barrier_post(unsigned* bar, volatile LAS unsigned* st) {
    XcdBarrier b; b.bar = bar; b.x = xb_xcc_id(); b.st = st;
    if (threadIdx.x == 0) (void)xb_add(&bar[XB_XCNT(b.x)], 1u);
    return b;
}
__device__ __forceinline__ void xcd_barrier_complete(unsigned* bar, unsigned x, unsigned& nloc, unsigned& nx) {
    const unsigned G = gridDim.x * gridDim.y * gridDim.z;
    unsigned sum, cnt, mine, sp = 0u;
    for (;;) {
        sum = 0u; cnt = 0u; mine = 0u;
#pragma unroll
        for (unsigned j = 0; j < 16; ++j) { const unsigned c = xb_ld(&bar[XB_XCNT(j)]); sum += c; cnt += (c > 0u) ? 1u : 0u; mine = (j == x) ? c : mine; }
        if (sum == G) break;
        __builtin_amdgcn_s_sleep(1);
        if ((++sp & 255u) == 0u) { if (xb_ld(&bar[XB_TMO])) break; if (sp > XB_SPIN_CAP) { atomicAdd(&bar[XB_TMO], 1u); break; } }
    }
    nloc = mine > 0u ? mine : 1u; nx = cnt > 0u ? cnt : 1u;
}

__device__ __forceinline__ void xcd_barrier(const XcdBarrier& b) {
    asm volatile("s_waitcnt vmcnt(0)" ::: "memory");
    __syncthreads();
    if (threadIdx.x == 0) {
        unsigned* bar = b.bar; asm volatile("" : "+s"(bar));
        __builtin_amdgcn_s_waitcnt(0);
        unsigned nloc = b.st[0], nx = b.st[1];
        if (nloc == 0u) { xcd_barrier_complete(bar, b.x, nloc, nx); b.st[0] = nloc; b.st[1] = nx; }
        const unsigned old = xb_add(&bar[XB_XSUB(b.x)], 1u);
        const unsigned gen = old / nloc;
        if (old + 1u == (gen + 1u) * nloc) {
            __builtin_amdgcn_fence(__ATOMIC_RELEASE, "agent");
            asm volatile("s_waitcnt vmcnt(0)" ::: "memory");
            const unsigned og = xb_add(&bar[XB_TOP], 1u);
            const unsigned tg = og / nx;
            if (og + 1u == (tg + 1u) * nx) xb_add(&bar[XB_TOPGEN], 1u);
            else XB_SPIN(xb_ld(&bar[XB_TOPGEN]) == tg, bar);
            __builtin_amdgcn_fence(__ATOMIC_ACQUIRE, "agent");
            xb_add(&bar[XB_XGEN(b.x)], 1u);
            asm volatile("s_waitcnt vmcnt(0)" ::: "memory");
        } else {
            XB_SPIN(xb_ld(&bar[XB_XGEN(b.x)]) == gen, bar);
            __builtin_amdgcn_fence(__ATOMIC_ACQUIRE, "agent");
            asm volatile("s_waitcnt vmcnt(0)" ::: "memory");
        }
    }
    __syncthreads();
}

__global__ void __launch_bounds__(NTHR, 2) mega_fwd(Params p) {
    extern __shared__ __attribute__((aligned(16))) unsigned char lds_raw[];
    LAS unsigned char* lds = (LAS unsigned char*)lds_raw;
    cg::grid_group grid = cg::this_grid();
    const int G = gridDim.x, bid = blockIdx.x;
#ifndef PROBE
#define PROBE 0
#endif
#define REP(k) _Pragma("unroll 1") for (int rep_ = 0; rep_ < ((PROBE == (k)) ? 2 : 1); ++rep_)
    volatile LAS unsigned* bst = (volatile LAS unsigned*)(lds + LDS_WORD_OFF + 16);
    if (threadIdx.x < 2) bst[threadIdx.x] = 0u;
    __syncthreads();
    const XcdBarrier bar = xcd_barrier_post((unsigned*)(p.ws + WS_CTL) + 1024, bst);
    REP(1) phase0(p, lds);
    if (gridDim.x == 0x7fffffffu) grid.sync();
    xcd_barrier(bar);
#pragma unroll 1
    for (int l = 0; l < 2; ++l) {
        REP(2) { phase_norm(p, l); }
        if (l == 0) { REP(3) phase_taps(p, lds); }
        xcd_barrier(bar);
        REP(4) {
            pg8::Gemm g{(const pg8::bf16_t*)(p.ws + WS_H), (const pg8::bf16_t*)(p.ws + WS_WIN) + (size_t)l * NIN * 2048, MTOK, NIN, 2048};
            pg8::StaticOrder S; S.init(MTOK, NIN, G, bid);
            EpiG1 E{(bf16*)(p.ws + WS_P), (bf16*)(p.ws + WS_ZT), (bf16*)(p.ws + WS_HT), p.out + (size_t)MTOK * DM + (size_t)32 * 2 * 256 * 1024, l};
            pg8::gemm_phase<EpiG1, pg8::StaticOrder, true, true>(lds, g, S, E);
        }
        xcd_barrier(bar);
        REP(5) phase_mix(p, lds, l, rep_);
        xcd_barrier(bar);
        _Pragma("unroll 1") for (int rep_ = 0; rep_ < ((PROBE == 6 && l == 0) ? 2 : 1); ++rep_) {
            pg8::Gemm g{(const pg8::bf16_t*)(p.ws + WS_YMIX), (const pg8::bf16_t*)(p.ws + WS_WBR) + (size_t)l * 2048 * 2048, MTOK, DM, 2048,
                        (const pg8::bf16_t*)(p.ws + WS_H), (const pg8::bf16_t*)(p.ws + WS_WOUT) + (size_t)l * 2048 * 2048};
            Order23 S{G, bid, (unsigned*)(p.ws + WS_CTL) + 8192 + l * 4096};
            EpiG23 E{EpiG2{(const bf16*)(p.ws + WS_P), (bf16*)(p.ws + WS_H)},
                     EpiG3{l == 0 ? p.in[I_XP] : p.out, l == 0 ? p.in[I_XS] : p.out + (size_t)NCTX * DM, p.out, (const float*)(p.ws + WS_ADA) + l * 3 * 6144}};
            pg8::gemm_phase<EpiG23, Order23, true, true>(lds, g, S, E);
        }
        if (l == 0) xcd_barrier(bar);
    }
#if PROBE == 13
    _Pragma("unroll 1") for (int i = 0; i < 20; ++i) grid.sync();
#endif
}

extern "C" void kernel_launch(void* const* d_in, const int* in_sizes, int n_in, void* d_out, int out_size, void* d_ws, size_t ws_size, hipStream_t stream) {
    static int grid = 0;
    if (grid == 0) {
        if (n_in != 24 || ws_size < WS_END) { fprintf(stderr, "kernel_launch: unexpected n_in %d / ws_size %zu\n", n_in, ws_size); grid = -1; return; }
        int dev = 0, cus = 0, per_cu = 0;
        hipGetDevice(&dev);
        hipDeviceGetAttribute(&cus, hipDeviceAttributeMultiprocessorCount, dev);
        hipFuncSetAttribute((const void*)mega_fwd, hipFuncAttributeMaxDynamicSharedMemorySize, LDS_BYTES);
        hipOccupancyMaxActiveBlocksPerMultiprocessor(&per_cu, (const void*)mega_fwd, NTHR, LDS_BYTES);
        (void)hipGetLastError();
        if (per_cu < 1) { fprintf(stderr, "kernel_launch: occupancy query says %d blocks per CU\n", per_cu); per_cu = 1; }
        grid = cus * 1;
    }
    if (grid < 0) return;
    hipMemsetAsync((char*)d_ws + WS_CTL, 0, CTL_BYTES, stream);
    Params p{};
    for (int i = 0; i < 24; ++i) p.in[i] = (const float*)d_in[i];
    p.out = (float*)d_out; p.ws = (unsigned char*)d_ws;
    void* args[] = {&p};
    hipError_t e = hipLaunchCooperativeKernel((const void*)mega_fwd, dim3(grid), dim3(NTHR), args, LDS_BYTES, stream);
    if (e != hipSuccess) fprintf(stderr, "cooperative launch failed: %s (grid %d)\n", hipGetErrorString(e), grid);
}
```

```cpp
#include <hip/hip_runtime.h>
#include <hip/hip_cooperative_groups.h>
#include <cstdio>
#include <cstdint>
namespace cg = cooperative_groups;

namespace pg8 {
#define PG8_LAS __attribute__((address_space(3)))
typedef unsigned short bf16_t;
typedef short bf16x8 __attribute__((ext_vector_type(8)));
typedef float f32x4 __attribute__((ext_vector_type(4)));
typedef unsigned u32x4 __attribute__((ext_vector_type(4)));
constexpr int BM = 256, BK = 64, HALF = 128, HTB = HALF * BK * 2  , STAGE_BYTES = 8 * HTB, NXCD = 8, WGM = 4;

__host__ __device__ __forceinline__ int lds_byte(int r, int c) { const int st = (r >> 4) * 2 + (c >> 5), rr = r & 15, cc = c & 31, ob = rr * 64 + cc * 2; return st * 1024 + (ob ^ (((ob >> 9) & 1) << 5)); }
__host__ __device__ __forceinline__ void stage_rc(int b, int& R, int& C) { const int st = b / 1024, sb = b % 1024, swz = sb ^ (((sb >> 9) & 1) << 5); R = (st >> 1) * 16 + swz / 64; C = (st & 1) * 32 + (swz % 64) / 2; }
__host__ __device__ __forceinline__ int perm32(int rho) { const int n = rho >> 4, i = rho & 15; return 8 * (i >> 2) + 4 * n + (i & 3); }

struct Unit { int pm, pn, kind; };
struct Gemm { const bf16_t* A; const bf16_t* Bt; int M, N, K; const bf16_t* A2; const bf16_t* Bt2; };

struct StaticOrder {
    int nM, nN, nwg, G, c;
    __host__ __device__ void init(int M, int N, int G_, int c_) { nM = M / BM; nN = N / BM; nwg = nM * nN; G = G_; c = c_; }
    __host__ __device__ bool next(int i, Unit& u) const {
        const long L = (long)i * G + c; if (L >= nwg) return false;
        int wgid = (int)L; { const int q = nwg / NXCD, r = nwg % NXCD, xcd = wgid % NXCD, off = wgid / NXCD; wgid = (xcd < r ? xcd * (q + 1) : r * (q + 1) + (xcd - r) * q) + off; }
        const int nig = WGM * nN, gid = wgid / nig, fm = gid * WGM, gsz = (nM - fm) < WGM ? (nM - fm) : WGM;
        u.pm = fm + ((wgid % nig) % gsz); u.pn = (wgid % nig) / gsz; u.kind = 0; return true;
    }
    __device__ __forceinline__ void a_ready(const Unit&) const {}
    __device__ __forceinline__ void done(const Unit&) const {}
};

__device__ __forceinline__ unsigned cvt_pk_bf16(float lo, float hi) { unsigned r; asm volatile("v_cvt_pk_bf16_f32 %0, %1, %2" : "=v"(r) : "v"(lo), "v"(hi)); return r; }
struct OneUnit {
    Unit u;
    __device__ bool next(int i, Unit& o) const { if (i != 0) return false; o = u; return true; }
    __device__ __forceinline__ void a_ready(const Unit&) const {}
    __device__ __forceinline__ void done(const Unit&) const {}
};
template <class Epi, class Sched, bool ALIGN_EPI = false, bool SP2 = false>
__device__ __forceinline__ void gemm_phase(PG8_LAS unsigned char* lds, const Gemm g, const Sched& S, const Epi& E) {
    int tid_o = threadIdx.x; asm volatile("" : "+v"(tid_o));
    const int tid = tid_o, wid = __builtin_amdgcn_readfirstlane(tid >> 6), lane = tid & 63, wr = wid >> 2, wc = wid & 3, fr = lane & 15, fq = lane >> 4;
    const int K = g.K, nt = K / BK;
    unsigned voffA[2], voffB[2];
#pragma unroll
    for (int i = 0; i < 2; ++i) { int R, C; stage_rc(tid * 16 + i * 8192, R, C); const int Rb = Epi::PERM ? ((R & ~31) + perm32(R & 31)) : R;
        voffA[i] = (unsigned)(R * K + C) * 2u; voffB[i] = (unsigned)(Rb * K + C) * 2u; }
    const size_t kstep = (size_t)(BK * 2);
    const size_t hstep = (size_t)HALF * K * 2;
    const size_t tstep = 2 * hstep;
    const unsigned ldsw = (unsigned)wid * 1024u;
    const int aoff = lds_byte(wr * 64 + fr, fq * 8), boff = lds_byte(wc * 32 + fr, fq * 8);
#define PG8_SA(b, h) (((b) * 2 + (h)) * HTB)
#define PG8_SB(b, h) ((4 + (b) * 2 + (h)) * HTB)
#define PG8_STAGE(bufoff, gbase, voff) do { _Pragma("unroll") for (int _i = 0; _i < 2; ++_i) \
        __builtin_amdgcn_global_load_lds((const unsigned*)((const char*)(gbase) + (voff)[_i]), (PG8_LAS unsigned*)(lds + (bufoff) + ldsw + _i * 8192), 16, 0, 0); } while (0)
#define PG8_LDA(dst, b, h) do { _Pragma("unroll") for (int m = 0; m < 4; ++m) _Pragma("unroll") for (int k = 0; k < 2; ++k) dst[m][k] = *(const PG8_LAS bf16x8*)(lds + PG8_SA(b, h) + aoff + m * 2048 + k * 1024); } while (0)
#define PG8_LDB(dst, b, h) do { _Pragma("unroll") for (int n = 0; n < 2; ++n) _Pragma("unroll") for (int k = 0; k < 2; ++k) dst[n][k] = *(const PG8_LAS bf16x8*)(lds + PG8_SB(b, h) + boff + n * 2048 + k * 1024); } while (0)
#define PG8_MMA(ai, bj, At, Bt) do { __builtin_amdgcn_s_setprio(1); _Pragma("unroll") for (int m = 0; m < 4; ++m) _Pragma("unroll") for (int n = 0; n < 2; ++n) _Pragma("unroll") for (int k = 0; k < 2; ++k) \
        acc[ai][bj][m][n] = __builtin_amdgcn_mfma_f32_16x16x32_bf16(Bt[n][k], At[m][k], acc[ai][bj][m][n], 0, 0, 0); __builtin_amdgcn_s_setprio(0); } while (0)
#define PG8_WAIT_V(n) asm volatile("s_waitcnt vmcnt(" #n ")" ::: "memory")
#define PG8_WAIT_L(n) asm volatile("s_waitcnt lgkmcnt(" #n ")" ::: "memory")
#define PG8_BAR __builtin_amdgcn_s_barrier()
#define PG8_SCHED __builtin_amdgcn_sched_barrier(0)
    Unit cur, nxt; int ui = 0;
    if (!S.next(0, cur)) return;
    f32x4 acc[2][2][4][2];
#pragma unroll
    for (int a = 0; a < 2; ++a)
#pragma unroll
        for (int b = 0; b < 2; ++b)
#pragma unroll
            for (int m = 0; m < 4; ++m)
#pragma unroll
                for (int n = 0; n < 2; ++n) acc[a][b][m][n] = (f32x4){0.f, 0.f, 0.f, 0.f};
    bf16x8 At[4][2], B0[2][2], B1[2][2];
    const char* cA = (const char*)(cur.kind ? g.A2 : g.A) + (size_t)cur.pm * tstep; const char* cB = (const char*)(cur.kind ? g.Bt2 : g.Bt) + (size_t)cur.pn * tstep;
    S.a_ready(cur);
    if constexpr (SP2) {
        PG8_STAGE(PG8_SB(0, 0), cB, voffB); PG8_STAGE(PG8_SB(0, 1), cB + hstep, voffB); PG8_STAGE(PG8_SA(0, 0), cA, voffA); PG8_STAGE(PG8_SA(0, 1), cA + hstep, voffA);
        if (wr == 1) PG8_BAR;
        PG8_WAIT_V(2); PG8_BAR;
        PG8_STAGE(PG8_SB(1, 0), cB + kstep, voffB); PG8_STAGE(PG8_SA(1, 0), cA + kstep, voffA); PG8_STAGE(PG8_SB(1, 1), cB + hstep + kstep, voffB);
        PG8_WAIT_V(6); PG8_BAR;
    } else {
        PG8_STAGE(PG8_SB(0, 0), cB, voffB); PG8_STAGE(PG8_SA(0, 0), cA, voffA); PG8_STAGE(PG8_SB(0, 1), cB + hstep, voffB); PG8_STAGE(PG8_SA(0, 1), cA + hstep, voffA);
        if (wr == 1) PG8_BAR;
        PG8_WAIT_V(4); PG8_BAR;
        PG8_STAGE(PG8_SB(1, 0), cB + kstep, voffB); PG8_STAGE(PG8_SA(1, 0), cA + kstep, voffA); PG8_STAGE(PG8_SB(1, 1), cB + hstep + kstep, voffB);
        PG8_WAIT_V(6); PG8_BAR;
    }
    for (;;) {
        const bool has_next = S.next(ui + 1, nxt);
        const char* nA = has_next ? (const char*)(nxt.kind ? g.A2 : g.A) + (size_t)nxt.pm * tstep : cA; const char* nB = has_next ? (const char*)(nxt.kind ? g.Bt2 : g.Bt) + (size_t)nxt.pn * tstep : cB;
        for (int t = 0; t < nt; t += 2) {
            const bool last = (t == nt - 2);
            if constexpr (Epi::HOOK) { if (cur.kind == 0 && (t == Epi::HK0 || t == Epi::HK1)) E.hook(acc, cur, t, wr, wc, fr, fq); }
            const char* a1 = cA + (size_t)(t + 1) * kstep;
            const char* a2 = last ? nA : cA + (size_t)(t + 2) * kstep; const char* b2 = last ? nB : cB + (size_t)(t + 2) * kstep;
            const char* a3 = a2 + kstep; const char* b3 = b2 + kstep;
            if (last && has_next) S.a_ready(nxt);
            if constexpr (SP2) {
            PG8_LDB(B0, 0, 0); PG8_LDB(B1, 0, 1); PG8_SCHED; PG8_LDA(At, 0, 0); PG8_STAGE(PG8_SA(1, 1), a1 + hstep, voffA);
            PG8_WAIT_V(8); PG8_WAIT_L(0); PG8_BAR; PG8_MMA(0, 0, At, B0); PG8_MMA(0, 1, At, B1); PG8_BAR; PG8_SCHED;
            PG8_LDA(At, 0, 1); PG8_STAGE(PG8_SB(0, 0), b2, voffB); PG8_STAGE(PG8_SB(0, 1), b2 + hstep, voffB); PG8_STAGE(PG8_SA(0, 0), a2, voffA);
            PG8_WAIT_V(8); PG8_WAIT_L(0); PG8_BAR; PG8_MMA(1, 0, At, B0); PG8_MMA(1, 1, At, B1); PG8_BAR; PG8_SCHED;
            PG8_LDB(B0, 1, 0); PG8_LDB(B1, 1, 1); PG8_SCHED; PG8_LDA(At, 1, 0); PG8_STAGE(PG8_SA(0, 1), a2 + hstep, voffA);
            PG8_WAIT_V(8); PG8_WAIT_L(0); PG8_BAR; PG8_MMA(0, 0, At, B0); PG8_MMA(0, 1, At, B1); PG8_BAR; PG8_SCHED;
            PG8_LDA(At, 1, 1); PG8_STAGE(PG8_SB(1, 0), b3, voffB); PG8_STAGE(PG8_SB(1, 1), b3 + hstep, voffB); PG8_STAGE(PG8_SA(1, 0), a3, voffA);
            PG8_WAIT_V(8); PG8_WAIT_L(0); PG8_BAR; PG8_MMA(1, 0, At, B0); PG8_MMA(1, 1, At, B1); PG8_BAR; PG8_SCHED;
            } else {
            PG8_LDB(B0, 0, 0); PG8_SCHED; PG8_LDA(At, 0, 0); PG8_STAGE(PG8_SA(1, 1), a1 + hstep, voffA);
            PG8_WAIT_L(8); PG8_BAR; PG8_WAIT_L(0); PG8_MMA(0, 0, At, B0); PG8_BAR; PG8_SCHED;
            PG8_LDB(B1, 0, 1); PG8_STAGE(PG8_SB(0, 0), b2, voffB);
            PG8_BAR; PG8_WAIT_L(0); PG8_MMA(0, 1, At, B1); PG8_BAR;
            PG8_LDA(At, 0, 1); PG8_STAGE(PG8_SA(0, 0), a2, voffA);
            PG8_BAR; PG8_WAIT_L(0); PG8_MMA(1, 0, At, B0); PG8_BAR; PG8_SCHED;
            PG8_STAGE(PG8_SB(0, 1), b2 + hstep, voffB);
            PG8_WAIT_V(6); PG8_BAR; PG8_MMA(1, 1, At, B1); PG8_BAR;
            PG8_LDB(B0, 1, 0); PG8_SCHED; PG8_LDA(At, 1, 0); PG8_STAGE(PG8_SA(0, 1), a2 + hstep, voffA);
            PG8_WAIT_L(8); PG8_BAR; PG8_WAIT_L(0); PG8_MMA(0, 0, At, B0); PG8_BAR; PG8_SCHED;
            PG8_LDB(B1, 1, 1); PG8_STAGE(PG8_SB(1, 0), b3, voffB);
            PG8_BAR; PG8_WAIT_L(0); PG8_MMA(0, 1, At, B1); PG8_BAR;
            PG8_LDA(At, 1, 1); PG8_STAGE(PG8_SA(1, 0), a3, voffA);
            PG8_BAR; PG8_WAIT_L(0); PG8_MMA(1, 0, At, B0); PG8_BAR; PG8_SCHED;
            PG8_STAGE(PG8_SB(1, 1), b3 + hstep, voffB);
            PG8_WAIT_V(6); PG8_BAR; PG8_MMA(1, 1, At, B1); PG8_BAR;
            }
        }
        if constexpr (ALIGN_EPI) { if (wr == 0) PG8_BAR; }
        if constexpr (!Epi::AFTER_DRAIN) { E(acc, cur, wr, wc, fr, fq); S.done(cur); }
        if (!has_next) break;
#pragma unroll
        for (int a = 0; a < 2; ++a)
#pragma unroll
            for (int b = 0; b < 2; ++b)
#pragma unroll
                for (int m = 0; m < 4; ++m)
#pragma unroll
                    for (int n = 0; n < 2; ++n) acc[a][b][m][n] = (f32x4){0.f, 0.f, 0.f, 0.f};
        cur = nxt; cA = nA; cB = nB; ++ui;
        if constexpr (ALIGN_EPI) { if (wr == 1) PG8_BAR; }
    }
    PG8_WAIT_V(0);
    if constexpr (!ALIGN_EPI) { if (wr == 0) PG8_BAR; }
    PG8_BAR;
    if constexpr (Epi::AFTER_DRAIN) { E.fused(acc, cur, wr, wc, fr, fq, lds, wid, lane); S.done(cur); }
#undef PG8_SA
#undef PG8_SB
#undef PG8_STAGE
#undef PG8_LDA
#undef PG8_LDB
#undef PG8_MMA
#undef PG8_WAIT_V
#undef PG8_WAIT_L
#undef PG8_BAR
#undef PG8_SCHED
}
}

#define LAS __attribute__((address_space(3)))
typedef unsigned short bf16;
typedef float f32x4 __attribute__((ext_vector_type(4)));
typedef float f32x2 __attribute__((ext_vector_type(2)));
typedef short bf16x8 __attribute__((ext_vector_type(8)));
typedef short s16x4 __attribute__((ext_vector_type(4)));
typedef unsigned u32x4 __attribute__((ext_vector_type(4)));
typedef unsigned u32x2 __attribute__((ext_vector_type(2)));

constexpr int DM = 2048, NCTX = 8192, NLAT = 4096, MTOK = 12288, NIN = 13312, NH = 8, HD = 128;
constexpr int OFF_Q = 0, OFF_K = 1024, OFF_V = 2048, OFF_GA = 3072, OFF_UB = 4096, OFF_GB = 4608, OFF_HC = 5120, OFF_GC = 6656, OFF_MG = 7168;
constexpr float EPS = 1e-6f;
constexpr float MIN_DECAY = -3.0701134573253945f, MAX_DECAY = -15.350567286626973f;
constexpr int NTHR = 512, NWAVES = 8;
constexpr int LDS_BYTES = 147456;
constexpr int LDS_WORD_OFF = 147392;

constexpr size_t MiB = 1u << 20;
constexpr size_t WS_CTL = 0, CTL_BYTES = 65536;
constexpr size_t WS_ADA = 1 * MiB;
constexpr size_t WS_HID = 2 * MiB;
constexpr size_t WS_WIN = 4 * MiB;
constexpr size_t WS_WBR = 108 * MiB;
constexpr size_t WS_WOUT = 124 * MiB;
constexpr size_t WS_DFTC = 140 * MiB;
constexpr size_t WS_DFTL = 141 * MiB;
constexpr size_t WS_KF = 160 * MiB;
constexpr size_t KF_LK0 = (size_t)2 * 512 * 528;
constexpr size_t KF_LK1 = (size_t)2 * 512 * 4112;
constexpr size_t KF_LAYER = KF_LK0 + KF_LK1;
constexpr size_t WS_CKB = 180 * MiB, WS_CVB = 184 * MiB;
constexpr size_t WS_H = 306 * MiB;
constexpr size_t WS_P = 354 * MiB;
constexpr size_t WS_ZT = 666 * MiB;
constexpr size_t WS_HT = 678 * MiB;
constexpr size_t WS_YMIX = 726 * MiB;
constexpr size_t WS_END = 774 * MiB;
static_assert(WS_KF + 2 * KF_LAYER * 2 <= WS_H, "kf");

struct Params { const float* in[24]; float* out; unsigned char* ws; };
enum { I_XP = 0, I_XS, I_CK, I_CV, I_C, I_CCTX, I_NG, I_WADA, I_BADA, I_WIN, I_QG, I_KG, I_RPB, I_CW, I_CB, I_FW1, I_FB1, I_FFREQ, I_FW2, I_FB2, I_FW3, I_HYB, I_WBR, I_WOUT };

__device__ __forceinline__ float bf2f(unsigned b) { return __uint_as_float(b << 16); }
__device__ __forceinline__ unsigned f2bf(float f) { unsigned u = __float_as_uint(f); return (u + 0x7fffu + ((u >> 16) & 1u)) >> 16; }
__device__ __forceinline__ unsigned pk2(float lo, float hi) { return pg8::cvt_pk_bf16(lo, hi); }
__device__ __forceinline__ float wave_sum(float v) {
#pragma unroll
    for (int o = 1; o < 64; o <<= 1) v += __shfl_xor(v, o);
    return v;
}
__device__ __forceinline__ float sigmoidf_(float x) { return 1.0f / (1.0f + __expf(-x)); }
__device__ __forceinline__ float siluf_(float x) { return x / (1.0f + __expf(-x)); }
__device__ __forceinline__ void unpack8(u32x4 w, float* f) {
    f[0] = bf2f(w.x & 0xffffu); f[1] = bf2f(w.x >> 16); f[2] = bf2f(w.y & 0xffffu); f[3] = bf2f(w.y >> 16);
    f[4] = bf2f(w.z & 0xffffu); f[5] = bf2f(w.z >> 16); f[6] = bf2f(w.w & 0xffffu); f[7] = bf2f(w.w >> 16);
}

struct EpiG1 {
    static constexpr bool PERM = true, AFTER_DRAIN = false, HOOK = false; static constexpr int HK0 = -1, HK1 = -1;
    bf16* P; bf16* ZT; bf16* HT; float* newv; int layer;
    __device__ __forceinline__ void hook(pg8::f32x4 (&acc)[2][2][4][2], const pg8::Unit& u, int t, int wr, int wc, int fr, int fq) const {}
    __device__ __forceinline__ void operator()(const pg8::f32x4 (&acc)[2][2][4][2], const pg8::Unit& u, int wr, int wc, int fr, int fq) const {
        const int pn = u.pn;
        const int rowb = u.pm * 256 + wr * 64 + fr, colb = pn * 256 + wc * 32 + 8 * fq;
        const bool tr = (pn == 16) || (pn == 17) || (pn >= 20 && pn <= 27);
        if (!tr) {
            const bool nv = (pn >= 8 && pn < 12 && u.pm < 32);
#pragma unroll
            for (int ai = 0; ai < 2; ++ai)
#pragma unroll
                for (int m = 0; m < 4; ++m) {
                    const int row = rowb + ai * 128 + m * 16;
#pragma unroll
                    for (int bj = 0; bj < 2; ++bj) {
                        const int col = colb + bj * 128;
                        const pg8::f32x4 v0 = acc[ai][bj][m][0], v1 = acc[ai][bj][m][1];
                        u32x4 w; w.x = pk2(v0[0], v0[1]); w.y = pk2(v0[2], v0[3]); w.z = pk2(v1[0], v1[1]); w.w = pk2(v1[2], v1[3]);
                        *(u32x4*)(P + (size_t)row * NIN + col) = w;
                        if (nv) {
                            const int b = row >> 8, t = row & 255;
                            float* o = newv + ((size_t)((b * 2 + layer) * 256 + t)) * 1024 + (col - OFF_V);
                            *(pg8::f32x4*)o = v0; *(pg8::f32x4*)(o + 4) = v1;
                        }
                    }
                }
        } else {
            int chb, nch; bf16* dst;
            if (pn < 18) { chb = colb - OFF_UB; nch = 512; dst = ZT; }
            else if (pn < 26) { chb = colb - OFF_HC; nch = 2048; dst = HT; }
            else { chb = 1536 + colb - OFF_GC; nch = 2048; dst = HT; }
            size_t base; int L;
            if (u.pm < 32) { L = 256; base = (size_t)u.pm * nch * 256; }
            else { L = 2048; const int lr = (u.pm - 32) * 256; base = (size_t)32 * nch * 256 + (size_t)(lr >> 11) * nch * 2048 + (lr & 2047); }
            const int posb = wr * 64 + fr;
#pragma unroll
            for (int ai = 0; ai < 2; ++ai)
#pragma unroll
                for (int m = 0; m < 4; ++m) {
                    const int pos = posb + ai * 128 + m * 16;
#pragma unroll
                    for (int bj = 0; bj < 2; ++bj) {
                        const int ch = chb + bj * 128;
#pragma unroll
                        for (int n = 0; n < 2; ++n)
#pragma unroll
                            for (int e = 0; e < 4; ++e)
                                dst[base + (size_t)(ch + 4 * n + e) * L + pos] = (bf16)f2bf(acc[ai][bj][m][n][e]);
                    }
                }
        }
    }
};

struct EpiG2 {
    static constexpr bool PERM = true, AFTER_DRAIN = false, HOOK = true; static constexpr int HK0 = 16, HK1 = 24;
    const bf16* P; bf16* MG;
    __device__ __forceinline__ void hook(pg8::f32x4 (&acc)[2][2][4][2], const pg8::Unit& u, int t, int wr, int wc, int fr, int fq) const {
        const int seg = (t == HK0) ? 0 : 1;
        int zo = 0; asm volatile("" : "+v"(zo));
        const int rowb = u.pm * 256 + wr * 64 + fr + zo, colb = u.pn * 256 + wc * 32 + 8 * fq;
        const bf16* pn_ = P + OFF_MG + seg * 2048 + colb; const bf16* pd_ = pn_ + 2048;
        u32x4 wn[2][2][2], wd[2][2][2];
#define G2_LOAD(buf, k) do { _Pragma("unroll") for (int m2 = 0; m2 < 2; ++m2) { const size_t ro = (size_t)(rowb + ((k) >> 1) * 128 + (((k) & 1) * 2 + m2) * 16) * NIN; \
            _Pragma("unroll") for (int bj = 0; bj < 2; ++bj) { wn[buf][m2][bj] = *(const u32x4*)(pn_ + ro + bj * 128); wd[buf][m2][bj] = *(const u32x4*)(pd_ + ro + bj * 128); } } } while (0)
        G2_LOAD(0, 0);
#pragma unroll
        for (int k = 0; k < 4; ++k) {
            const int ai = k >> 1, mh = k & 1;
            if (k < 3) G2_LOAD((k + 1) & 1, k + 1);
#pragma unroll
            for (int m2 = 0; m2 < 2; ++m2)
#pragma unroll
                for (int bj = 0; bj < 2; ++bj) {
                    float fn[8], fd[8]; unpack8(wn[k & 1][m2][bj], fn); unpack8(wd[k & 1][m2][bj], fd);
#pragma unroll
                    for (int e = 0; e < 8; ++e) { const float r = (1.0f + __expf(-fd[e])) * __builtin_amdgcn_rcpf(1.0f + __expf(-fn[e])); acc[ai][bj][mh * 2 + m2][e >> 2][e & 3] *= r; }
                }
            asm volatile("" ::: "memory");
        }
#undef G2_LOAD
    }
    __device__ __forceinline__ void operator()(const pg8::f32x4 (&acc)[2][2][4][2], const pg8::Unit& u, int wr, int wc, int fr, int fq) const {
        const int rowb = u.pm * 256 + wr * 64 + fr, colb = u.pn * 256 + wc * 32 + 8 * fq;
        const __amdgpu_buffer_rsrc_t mg_rsrc = __builtin_amdgcn_make_buffer_rsrc((void*)MG, 0, MTOK * DM * 2, 0x00020000);
#pragma unroll
        for (int ai = 0; ai < 2; ++ai) {
            u32x4 wg[4][2];
#pragma unroll
            for (int m = 0; m < 4; ++m)
#pragma unroll
                for (int bj = 0; bj < 2; ++bj) wg[m][bj] = *(const u32x4*)(P + (size_t)(rowb + ai * 128 + m * 16) * NIN + OFF_MG + 4096 + colb + bj * 128);
#pragma unroll
            for (int m = 0; m < 4; ++m) {
                const int row = rowb + ai * 128 + m * 16;
#pragma unroll
                for (int bj = 0; bj < 2; ++bj) {
                    const int col = colb + bj * 128;
                    float g[8]; unpack8(wg[m][bj], g);
                    float v[8];
#pragma unroll
                    for (int e = 0; e < 8; ++e) v[e] = acc[ai][bj][m][e >> 2][e & 3] * sigmoidf_(g[e]);
                    u32x4 w; w.x = pk2(v[0], v[1]); w.y = pk2(v[2], v[3]); w.z = pk2(v[4], v[5]); w.w = pk2(v[6], v[7]);
                    __builtin_amdgcn_raw_buffer_store_b128(w, mg_rsrc, (unsigned)(((size_t)row * DM + col) * 2), 0,   16);
                }
            }
            asm volatile("" ::: "memory");
        }
    }
};

struct EpiG3 {
    static constexpr bool PERM = true, AFTER_DRAIN = false, HOOK = false; static constexpr int HK0 = -1, HK1 = -1;
    const float* xc; const float* xl; float* out; const float* ada_l;
    __device__ __forceinline__ void hook(pg8::f32x4 (&acc)[2][2][4][2], const pg8::Unit& u, int t, int wr, int wc, int fr, int fq) const {}
    __device__ __forceinline__ void operator()(const pg8::f32x4 (&acc)[2][2][4][2], const pg8::Unit& u, int wr, int wc, int fr, int fq) const {
        const int rowb = u.pm * 256 + wr * 64 + fr, colb = u.pn * 256 + wc * 32 + 8 * fq;
        const bool isc = u.pm < 32;
        const int cv = isc ? 0 : 1 + ((u.pm - 32) >> 3);
        const float* gate = ada_l + cv * 6144 + 4096;
        const float* xb = isc ? xc : xl - (size_t)NCTX * DM;
        pg8::f32x4 gv[2][2];
#pragma unroll
        for (int bj = 0; bj < 2; ++bj)
#pragma unroll
            for (int n = 0; n < 2; ++n) gv[bj][n] = *(const pg8::f32x4*)(gate + colb + bj * 128 + n * 4);
#pragma unroll
        for (int ai = 0; ai < 2; ++ai)
#pragma unroll
            for (int m = 0; m < 4; ++m) {
                const size_t ro = (size_t)(rowb + ai * 128 + m * 16) * DM;
#pragma unroll
                for (int bj = 0; bj < 2; ++bj)
#pragma unroll
                    for (int n = 0; n < 2; ++n) {
                        const int col = colb + bj * 128 + n * 4;
                        const pg8::f32x4 xv = *(const pg8::f32x4*)(xb + ro + col);
                        *(pg8::f32x4*)(out + ro + col) = xv + gv[bj][n] * acc[ai][bj][m][n];
                    }
                if (m == 3) asm volatile("" ::: "memory");
            }
    }
};
struct EpiG23 {
    static constexpr bool PERM = true, AFTER_DRAIN = false, HOOK = true; static constexpr int HK0 = 16, HK1 = 24;
    EpiG2 e2; EpiG3 e3;
    __device__ __forceinline__ void hook(pg8::f32x4 (&acc)[2][2][4][2], const pg8::Unit& u, int t, int wr, int wc, int fr, int fq) const { e2.hook(acc, u, t, wr, wc, fr, fq); }
    __device__ __forceinline__ void operator()(const pg8::f32x4 (&acc)[2][2][4][2], const pg8::Unit& u, int wr, int wc, int fr, int fq) const {
        if (u.kind == 0) e2(acc, u, wr, wc, fr, fq); else e3(acc, u, wr, wc, fr, fq);
    }
};
struct Order23 {
    int G, c; unsigned* cnt;
    __device__ bool next(int i, pg8::Unit& u) const { const int v = i * G + ((G == 256) ? 32 * (c & 7) + (c >> 3) : c); if (v >= 768) return false;     const int k = v >= 384 ? 1 : 0, w = v - 384 * k; u.pm = w >> 3; u.pn = w & 7; u.kind = k; return true; }
    __device__ __forceinline__ void a_ready(const pg8::Unit& u) const {
        if (u.kind) {
            unsigned* cp = cnt + 64 * u.pm; unsigned sp = 0;
            while (__hip_atomic_load(cp, __ATOMIC_RELAXED, __HIP_MEMORY_SCOPE_AGENT) < 64u) { __builtin_amdgcn_s_sleep(2); if (++sp > (1u << 22)) break; }
            __builtin_amdgcn_fence(__ATOMIC_ACQUIRE, "agent");
            asm volatile("s_waitcnt vmcnt(0)" ::: "memory");
        }
    }
    __device__ __forceinline__ void done(const pg8::Unit& u) const {
        if (!u.kind) {
            asm volatile("s_waitcnt vmcnt(0)" ::: "memory");
            __builtin_amdgcn_s_barrier();
            if (threadIdx.x == 0) __hip_atomic_fetch_add(cnt + 64 * u.pm, 8u, __ATOMIC_RELAXED, __HIP_MEMORY_SCOPE_AGENT);
        }
    }
};

struct EpiF {
    static constexpr bool PERM = false, AFTER_DRAIN = false, HOOK = false; static constexpr int HK0 = -1, HK1 = -1;
    const bf16* P; bf16* Y; int lat;
    __device__ __forceinline__ void hook(pg8::f32x4 (&acc)[2][2][4][2], const pg8::Unit& u, int t, int wr, int wc, int fr, int fq) const {}
    __device__ __forceinline__ void operator()(const pg8::f32x4 (&acc)[2][2][4][2], const pg8::Unit& u, int wr, int wc, int fr, int fq) const {
        const int batch = u.pn >> 1, gb = (u.pn & 1) * 2;
        const int tok0 = lat ? NCTX + batch * 2048 : batch * 256;
#pragma unroll
        for (int m = 0; m < 4; ++m) {
            const int k = u.pm * 128 + wr * 64 + m * 16 + fr;
            const size_t tok = (size_t)(tok0 + k);
#pragma unroll
            for (int bj = 0; bj < 2; ++bj) {
                const int g = gb + bj;
                const bf16* gp = P + tok * NIN + OFF_GB + g * 128;
                bf16* yp = Y + tok * DM + 1024 + g * 128;
#pragma unroll
                for (int n = 0; n < 2; ++n) {
                    const pg8::f32x4 C = acc[0][bj][m][n], S = acc[1][bj][m][n];
                    const int s0 = wc * 32 + n * 16 + fq * 4;
#pragma unroll
                    for (int pr = 0; pr < 2; ++pr) {
                        const int s = s0 + 2 * pr;
                        const float ce = C[2 * pr], co = C[2 * pr + 1], so = S[2 * pr + 1];
                        int c0, c1; float y0, y1;
                        if (s == 0) { c0 = 0; c1 = 64; y0 = ce; y1 = co; }
                        else { c0 = s >> 1; c1 = 128 - c0; y0 = ce - so; y1 = ce + so; }
                        yp[c0] = (bf16)f2bf(y0 * siluf_(bf2f(gp[c0])));
                        yp[c1] = (bf16)f2bf(y1 * siluf_(bf2f(gp[c1])));
                    }
                }
            }
        }
    }
};

__device__ __forceinline__ void p0_transpose_item(const float* W, int K, int N, bf16* WT, LAS float* scr, int kb, int nb, int lane) {
    const int k0 = 64 * kb, n0 = 32 * nb;
#pragma unroll
    for (int i = 0; i < 32; ++i) { const int kk = 2 * i + (lane >> 5); scr[kk * 33 + (lane & 31)] = W[(size_t)(k0 + kk) * N + n0 + (lane & 31)]; }
    asm volatile("s_waitcnt lgkmcnt(0)" ::: "memory");
    const int c = lane & 7;
#pragma unroll
    for (int j = 0; j < 4; ++j) { const int n = (lane >> 3) + 8 * j; const LAS float* s = scr + (8 * c) * 33 + n;
        u32x4 o; o.x = pk2(s[0 * 33], s[1 * 33]); o.y = pk2(s[2 * 33], s[3 * 33]); o.z = pk2(s[4 * 33], s[5 * 33]); o.w = pk2(s[6 * 33], s[7 * 33]);
        *(u32x4*)(WT + (size_t)(n0 + n) * K + k0 + 8 * c) = o; }
    asm volatile("s_waitcnt lgkmcnt(0)" ::: "memory");
}

__device__ __forceinline__ void ada_item(const Params& p, LAS unsigned char* lds, const int tid, int it) {
    const int lane = tid & 63, wave = tid >> 6;
    LAS float* sc = (LAS float*)lds; LAS float* red = (LAS float*)(lds + 24576);
    float* ada = (float*)(p.ws + WS_ADA);
    const int l = it / 96, cgp = it % 96;
    __syncthreads();
    for (int i = tid; i < 3 * 2048; i += NTHR) { const int cv = i >> 11, k = i & 2047; const float v = cv == 0 ? p.in[I_CCTX][k] : p.in[I_C][(cv - 1) * 2048 + k]; sc[i] = siluf_(v); }
    __syncthreads();
    const int col = cgp * 64 + lane, kp = wave;
    const float* w = p.in[I_WADA] + (size_t)l * 2048 * 6144 + (size_t)(kp * 256) * 6144 + col;
    float a0 = 0.f, a1 = 0.f, a2 = 0.f;
#pragma unroll 32
    for (int k = 0; k < 256; ++k) { const float wv = w[(size_t)k * 6144]; a0 += sc[kp * 256 + k] * wv; a1 += sc[2048 + kp * 256 + k] * wv; a2 += sc[4096 + kp * 256 + k] * wv; }
    red[(kp * 64 + lane) * 3 + 0] = a0; red[(kp * 64 + lane) * 3 + 1] = a1; red[(kp * 64 + lane) * 3 + 2] = a2;
    __syncthreads();
    if (tid < 192) { const int cv = tid / 64, cc = tid % 64; float s = 0.f;
#pragma unroll
        for (int q = 0; q < 8; ++q) s += red[(q * 64 + cc) * 3 + cv];
        ada[(l * 3 + cv) * 6144 + cgp * 64 + cc] = s + p.in[I_BADA][l * 6144 + cgp * 64 + cc]; }
}
__device__ __forceinline__ void fold_item(const Params& p, LAS unsigned char* lds, const int tid, int it) {
    const int lane = tid & 63, wave = tid >> 6;
    LAS float* Wsub = (LAS float*)lds; LAS float* ctab = (LAS float*)(lds + 64 * 129 * 4); LAS float* stab = ctab + 128;
    bf16* WT = (bf16*)(p.ws + WS_WIN);
    const int l = it >> 7, kb = (it >> 2) & 31, g = it & 3;
    __syncthreads();
    if (tid < 128) { ctab[tid] = cospif((float)tid * (1.0f / 64.0f)); stab[tid] = sinpif((float)tid * (1.0f / 64.0f)); }
    for (int i = tid; i < 64 * 128; i += NTHR) { const int kk = i >> 7, cc = i & 127; Wsub[kk * 129 + cc] = p.in[I_WIN][((size_t)l * 2048 + kb * 64 + kk) * NIN + OFF_UB + g * 128 + cc]; }
    __syncthreads();
    for (int si = 0; si < 16; ++si) {
        const int slot = wave * 16 + si;
        int m; bool isS; if (slot == 0) { m = 0; isS = false; } else if (slot == 1) { m = 64; isS = false; } else { m = slot >> 1; isS = (slot & 1) != 0; }
        const LAS float* tab = isS ? stab : ctab;
        float a = 0.f;
#pragma unroll 8
        for (int cc = 0; cc < 128; ++cc) a += Wsub[lane * 129 + cc] * tab[(m * cc) & 127];
        a *= 0.08838834764831845f;
        WT[((size_t)l * NIN + OFF_UB + g * 128 + slot) * 2048 + kb * 64 + lane] = (bf16)f2bf(a);
    }
}
constexpr int TR_IN = 32 * 416, TR_SQ = 32 * 64, TR_LAYER = TR_IN + 2 * TR_SQ;
__device__ __forceinline__ void transpose_witem(const Params& p, LAS float* scr, const int lane, int it) {
    const int l = it / TR_LAYER; int r = it % TR_LAYER;
    if (r < TR_IN) { const int kb = r / 416, nb = r % 416;
        if (nb >= 128 && nb < 144) return;
        p0_transpose_item(p.in[I_WIN] + (size_t)l * 2048 * NIN, 2048, NIN, (bf16*)(p.ws + WS_WIN) + (size_t)l * NIN * 2048, scr, kb, nb, lane); return; }
    r -= TR_IN;
    if (r < TR_SQ) { p0_transpose_item(p.in[I_WBR] + (size_t)l * 2048 * 2048, 2048, 2048, (bf16*)(p.ws + WS_WBR) + (size_t)l * 2048 * 2048, scr, r / 64, r % 64, lane); return; }
    r -= TR_SQ;
    p0_transpose_item(p.in[I_WOUT] + (size_t)l * 2048 * 2048, 2048, 2048, (bf16*)(p.ws + WS_WOUT) + (size_t)l * 2048 * 2048, scr, r / 64, r % 64, lane);
}

__device__ __forceinline__ void phase0(const Params& p, LAS unsigned char* lds) {
    int tid_o = threadIdx.x; asm volatile("" : "+v"(tid_o));
    const int tid = tid_o, lane = tid & 63, wave = tid >> 6;
    const int G = gridDim.x, bid = blockIdx.x;
    unsigned char* ws = p.ws;
    for (int it = bid; it < 192; it += G) ada_item(p, lds, tid, it);
    for (int it = bid; it < 256; it += G) fold_item(p, lds, tid, it);
    __syncthreads();
    {
        LAS float* scr = (LAS float*)(lds + wave * 16384);
        const int gw = bid * NWAVES + wave, NGW = G * NWAVES;
        for (int it = gw; it < 2 * TR_LAYER; it += NGW) transpose_witem(p, scr, lane, it);
        float* HID = (float*)(ws + WS_HID);
        for (int r = gw; r < 2 * 2304; r += NGW) {
            const int l = r / 2304, rr = r % 2304, lk = rr < 256 ? 0 : 1, t = lk ? rr - 256 : rr, L = lk ? 2048 : 256;
            const float tt = (float)t / (float)(L - 1), w = (6.283185307179586f / (float)L) * (float)t;
            const float fstep = (15.0f - 1e-4f) / 15.0f;
            float zi = 0.f;
            if (lane == 0) zi = tt; else if (lane <= 16) zi = cosf(w * (1e-4f + (float)(lane - 1) * fstep)); else if (lane <= 32) zi = -sinf(w * (1e-4f + (float)(lane - 17) * fstep));
            const float fr_ = p.in[I_FFREQ][l * 64 + lane];
            float a = p.in[I_FB1][l * 64 + lane];
            for (int i = 0; i < 33; ++i) a += __shfl(zi, i) * p.in[I_FW1][(l * 33 + i) * 64 + lane];
            const float h1 = sinf(fr_ * a);
            float a2 = p.in[I_FB2][l * 64 + lane];
            for (int i = 0; i < 64; ++i) a2 += __shfl(h1, i) * p.in[I_FW2][(l * 64 + i) * 64 + lane];
            HID[((size_t)(l * 2 + lk) * 2048 + t) * 64 + lane] = sinf(fr_ * a2);
        }
    }
    {
        bf16* ckb = (bf16*)(ws + WS_CKB); bf16* cvb = (bf16*)(ws + WS_CVB);
        const int nch = 2 * 2 * 512 * 1024 / 8;
        for (int ch = bid * NTHR + tid; ch < 2 * nch; ch += G * NTHR) {
            const int which = ch >= nch, i = (which ? ch - nch : ch) * 8;
            const float* src = (which ? p.in[I_CV] : p.in[I_CK]) + i;
            const f32x4 a = *(const f32x4*)src, b2 = *(const f32x4*)(src + 4);
            u32x4 o; o.x = pk2(a.x, a.y); o.y = pk2(a.z, a.w); o.z = pk2(b2.x, b2.y); o.w = pk2(b2.z, b2.w);
            *(u32x4*)((which ? cvb : ckb) + i) = o;
        }
    }
    {
        bf16* DC = (bf16*)(ws + WS_DFTC); bf16* DL = (bf16*)(ws + WS_DFTL);
        const int total = 16384 + 1048576;
        for (int ch = bid * NTHR + tid; ch < total; ch += G * NTHR) {
            int L, e0; bf16* base; float sc;
            if (ch < 16384) { L = 256; base = DC; e0 = ch * 8; sc = 0.0625f; } else { L = 2048; base = DL; e0 = (ch - 16384) * 8; sc = 0.02209708691207961f; }
            const int rho = e0 / L, l0 = e0 % L, k = (rho >> 8) * 128 + (rho & 127), ty = (rho >> 7) & 1;
            float v[8];
#pragma unroll
            for (int e = 0; e < 8; ++e) { const int r = (k * (l0 + e)) & (L - 1); const float x = 2.0f * (float)r / (float)L; v[e] = (ty ? sinpif(x) : cospif(x)) * sc; }
            u32x4 o; o.x = pk2(v[0], v[1]); o.y = pk2(v[2], v[3]); o.z = pk2(v[4], v[5]); o.w = pk2(v[6], v[7]);
            *(u32x4*)(base + e0) = o;
        }
    }
}

template <int L>
__device__ __forceinline__ void taps_item(const Params& p, LAS unsigned char* lds, const int tid, int l, int o, int cgi) {
    constexpr bool HV = (L == 2048);
    constexpr int NC = HV ? 8 : 16, NCOLS = 2 * NC, TPT = HV ? 4 : 1, RS = 2 * L, Lp = 2 * L + 16, lk = HV ? 1 : 0;
    const int lane = tid & 63, wave = tid >> 6;
    LAS float* w3s = (LAS float*)lds; LAS float* red = (LAS float*)(lds + 8192); LAS float* tot = (LAS float*)(lds + 8192 + 512); LAS bf16* Rb = (LAS bf16*)(lds + 16384);
    const float* hid = (const float*)(p.ws + WS_HID) + (size_t)(l * 2 + lk) * 2048 * 64;
    __syncthreads();
    for (int i = tid; i < NCOLS * 64; i += NTHR) { const int lc = i >> 6, j = i & 63, dir = lc / NC, c = cgi * NC + lc % NC; w3s[i] = p.in[I_FW3][(size_t)(l * 64 + j) * 2048 + o * 1024 + dir * 512 + c]; }
    if (tid < NC) Rb[tid * RS] = 0;
    if (tid < 128) red[tid] = 0.f;
    __syncthreads();
    constexpr int NTW = HV ? 16 : 4;
    const int q = lane & 15, sgrp = lane >> 4;
    const int nt = HV ? 0 : (wave & 1), tile0 = HV ? wave * 16 : (wave >> 1) * 4;
    const int lc = nt * 16 + q, dir = lc / NC, ci = lc % NC, cch = cgi * NC + ci;
    float bfr[16];
#pragma unroll
    for (int kk = 0; kk < 16; ++kk) bfr[kk] = w3s[lc * 64 + 16 * sgrp + kk];
    f32x4 acc[NTW];
#pragma unroll
    for (int i = 0; i < NTW; ++i) {
        const int t0 = (tile0 + i) * 16;
        const f32x4* hr = (const f32x4*)(hid + (size_t)(t0 + q) * 64 + 16 * sgrp);
        const f32x4 h0 = hr[0], h1 = hr[1], h2 = hr[2], h3 = hr[3];
        f32x4 a = (f32x4){0.f, 0.f, 0.f, 0.f};
        a = __builtin_amdgcn_mfma_f32_16x16x4f32(h0.x, bfr[0], a, 0, 0, 0); a = __builtin_amdgcn_mfma_f32_16x16x4f32(h0.y, bfr[1], a, 0, 0, 0);
        a = __builtin_amdgcn_mfma_f32_16x16x4f32(h0.z, bfr[2], a, 0, 0, 0); a = __builtin_amdgcn_mfma_f32_16x16x4f32(h0.w, bfr[3], a, 0, 0, 0);
        a = __builtin_amdgcn_mfma_f32_16x16x4f32(h1.x, bfr[4], a, 0, 0, 0); a = __builtin_amdgcn_mfma_f32_16x16x4f32(h1.y, bfr[5], a, 0, 0, 0);
        a = __builtin_amdgcn_mfma_f32_16x16x4f32(h1.z, bfr[6], a, 0, 0, 0); a = __builtin_amdgcn_mfma_f32_16x16x4f32(h1.w, bfr[7], a, 0, 0, 0);
        a = __builtin_amdgcn_mfma_f32_16x16x4f32(h2.x, bfr[8], a, 0, 0, 0); a = __builtin_amdgcn_mfma_f32_16x16x4f32(h2.y, bfr[9], a, 0, 0, 0);
        a = __builtin_amdgcn_mfma_f32_16x16x4f32(h2.z, bfr[10], a, 0, 0, 0); a = __builtin_amdgcn_mfma_f32_16x16x4f32(h2.w, bfr[11], a, 0, 0, 0);
        a = __builtin_amdgcn_mfma_f32_16x16x4f32(h3.x, bfr[12], a, 0, 0, 0); a = __builtin_amdgcn_mfma_f32_16x16x4f32(h3.y, bfr[13], a, 0, 0, 0);
        a = __builtin_amdgcn_mfma_f32_16x16x4f32(h3.z, bfr[14], a, 0, 0, 0); a = __builtin_amdgcn_mfma_f32_16x16x4f32(h3.w, bfr[15], a, 0, 0, 0);
        acc[i] = a;
    }
    const float delta = fabsf(MIN_DECAY + (float)cch * ((MAX_DECAY - MIN_DECAY) / 511.0f));
    float asum = 0.f;
#pragma unroll
    for (int i = 0; i < NTW; ++i)
#pragma unroll
        for (int e2 = 0; e2 < 4; ++e2) { const int t = (tile0 + i) * 16 + 4 * sgrp + e2; const float v = acc[i][e2] * __expf(-((float)t * (1.0f / (float)(L - 1))) * delta); acc[i][e2] = v; asum += fabsf(v); }
    asum += __shfl_xor(asum, 16); asum += __shfl_xor(asum, 32);
    if (lane < 16) red[wave * 16 + lane] = asum;
    __syncthreads();
    if (tid < NCOLS) { float s2 = 0.f;
        if (HV) {
#pragma unroll
            for (int w = 0; w < 8; ++w) s2 += red[w * 16 + tid]; }
        else {
#pragma unroll
            for (int w = 0; w < 4; ++w) s2 += red[(2 * w + (tid >> 4)) * 16 + (tid & 15)]; }
        tot[tid] = 1.0f / (s2 + EPS); }
    __syncthreads();
    const float inv = tot[lc];
#pragma unroll
    for (int i = 0; i < NTW; ++i)
#pragma unroll
        for (int e2 = 0; e2 < 4; ++e2) { const int t = (tile0 + i) * 16 + 4 * sgrp + e2; const int x = dir ? L + t : L - t;
            if (!(dir && t == 0)) Rb[ci * RS + x] = (bf16)f2bf(acc[i][e2] * inv); }
    __syncthreads();
    constexpr int nchunk = (2 * L) / 8;
    bf16* dst = (bf16*)(p.ws + WS_KF) + (size_t)l * KF_LAYER + (lk ? KF_LK0 : 0) + (size_t)(o * 512 + cgi * NC) * Lp;
    for (int i = tid; i < NC * nchunk; i += NTHR) {
        const int cc = i / nchunk, y0 = (i % nchunk) * 8;
        *(u32x4*)(dst + (size_t)cc * Lp + y0) = *(const LAS u32x4*)(Rb + cc * RS + y0);
    }
}
__device__ __forceinline__ void taps_any(const Params& p, LAS unsigned char* lds, const int tid, int l, int j) {
    if (j < 128) taps_item<2048>(p, lds, tid, l, j >> 6, j & 63);
    else { const int r = j - 128; taps_item<256>(p, lds, tid, l, r >> 5, r & 31); }
}
__device__ __forceinline__ void phase_taps(const Params& p, LAS unsigned char* lds) {
    for (int it = blockIdx.x; it < 384; it += gridDim.x) {
        int tid = threadIdx.x; asm volatile("" : "+v"(tid));
        taps_any(p, lds, tid, it & 1, it >> 1);
    }
    __syncthreads();
}

__device__ __forceinline__ void phase_norm(const Params& p, int l) {
    int tid_o = threadIdx.x; asm volatile("" : "+v"(tid_o));
    const int tid = tid_o, lane = tid & 63, wave = tid >> 6;
    const int gw = blockIdx.x * NWAVES + wave, NGW = gridDim.x * NWAVES;
    bf16* H = (bf16*)(p.ws + WS_H);
    const float* ada = (const float*)(p.ws + WS_ADA);
    for (int row = gw; row < MTOK; row += NGW) {
        const float* x = (l == 0) ? (row < NCTX ? p.in[I_XP] + (size_t)row * DM : p.in[I_XS] + (size_t)(row - NCTX) * DM) : p.out + (size_t)row * DM;
        const int cv = row < NCTX ? 0 : 1 + ((row - NCTX) >> 11);
        f32x4 v[8]; float ss = 0.f;
#pragma unroll
        for (int j = 0; j < 8; ++j) { v[j] = ((const f32x4*)x)[lane + 64 * j]; ss += v[j].x * v[j].x + v[j].y * v[j].y + v[j].z * v[j].z + v[j].w * v[j].w; }
        ss = wave_sum(ss);
        const float rs = rsqrtf(ss * (1.0f / 2048.0f) + EPS);
        const float* ad = ada + (l * 3 + cv) * 6144;
        const float* ng = p.in[I_NG] + l * 2048;
#pragma unroll
        for (int j = 0; j < 8; ++j) {
            const int idx = (lane + 64 * j) * 4;
            const f32x4 g4 = *(const f32x4*)(ng + idx), sh = *(const f32x4*)(ad + idx), sc = *(const f32x4*)(ad + 2048 + idx);
            const f32x4 h = v[j] * rs * g4 * (sc + 1.0f) + sh;
            u32x2 w; w.x = pk2(h.x, h.y); w.y = pk2(h.z, h.w);
            *(u32x2*)(H + (size_t)row * DM + idx) = w;
        }
    }
}

constexpr int AT_KS = 0, AT_VT = 17408, AT_BUF = 36864;
__device__ __forceinline__ void attn_unit(const Params& p, LAS unsigned char* lds, const int tid, int kind, int b, int h, int sub, int layer) {
    const int lane = tid & 63, wave = tid >> 6, q16 = lane & 15, g = lane >> 4;
    const bf16* P = (const bf16*)(p.ws + WS_P);
    bf16* Y = (bf16*)(p.ws + WS_YMIX);
    LAS float* rpbL = (LAS float*)(lds + 2 * AT_BUF);
    const float* qg = p.in[I_QG] + layer * 128; const float* kg = p.in[I_KG] + layer * 128;
    int tokq, r = 0, qc = 0, cs = 0, rs_ = 0;
    if (kind == 0) tokq = b * 256 + sub * 128 + wave * 16 + q16;
    else { r = 2 * sub + (wave >> 2); qc = (wave & 3) * 16 + q16; tokq = NCTX + b * 2048 + r * 64 + qc; cs = min(max(qc - 8, 0), 48); rs_ = min(max(r - 4, 0), 24); }
    int kr0 = 0, nwin = 0;
    if (kind == 1) { const int r0 = 2 * sub; kr0 = min(max(r0 - 4, 0), 24); const int kr1 = min(max(r0 + 1 - 4, 0), 24) + 7; nwin = kr1 - kr0 + 1; }
    const int nchunks = kind == 0 ? 4 : nwin + 8;
    u32x4 kA0, kA1, vA0, vA1, kB0, kB1, vB0, vB1;
    const int kkey = tid >> 3, kd = (tid & 7) * 16, vkey = lane, vd = wave * 16;
    float kgv[16];
#pragma unroll
    for (int j = 0; j < 4; ++j) { const f32x4 g4 = *(const f32x4*)(kg + kd + 4 * j); kgv[4 * j] = g4.x; kgv[4 * j + 1] = g4.y; kgv[4 * j + 2] = g4.z; kgv[4 * j + 3] = g4.w; }
    const bf16* CKB = (const bf16*)(p.ws + WS_CKB); const bf16* CVB = (const bf16*)(p.ws + WS_CVB);
#define AT_LOAD(ci, K0, K1, V0, V1) do { if ((ci) < nchunks) { \
        const bf16* pk; const bf16* pv; \
        if (kind == 1 && (ci) >= nwin) { \
            const int cc = (ci) - nwin; \
            pk = CKB + ((size_t)((b * 2 + layer) * 512 + cc * 64 + kkey) * 8 + h) * 128 + kd; \
            pv = CVB + ((size_t)((b * 2 + layer) * 512 + cc * 64 + vkey) * 8 + h) * 128 + vd; \
        } else { \
            const int tk0 = kind == 0 ? b * 256 + (ci) * 64 : NCTX + b * 2048 + (kr0 + (ci)) * 64; \
            pk = P + (size_t)(tk0 + kkey) * NIN + OFF_K + h * 128 + kd; \
            pv = P + (size_t)(tk0 + vkey) * NIN + OFF_V + h * 128 + vd; \
        } \
        K0 = *(const u32x4*)pk; K1 = *(const u32x4*)(pk + 8); V0 = *(const u32x4*)pv; V1 = *(const u32x4*)(pv + 8); } } while (0)
#define AT_CHUNK(ci, K0, K1, V0, V1) do { \
        const bool cached = (kind == 1 && (ci) >= nwin); \
        LAS bf16* Ks = (LAS bf16*)(lds + ((ci) & 1) * AT_BUF + AT_KS); LAS bf16* Vt = (LAS bf16*)(lds + ((ci) & 1) * AT_BUF + AT_VT);     \
        { \
            float kv[16]; \
            unpack8(K0, kv); unpack8(K1, kv + 8); \
            u32x4 w0 = K0, w1 = K1; \
            if (!cached) { \
                float ss = 0.f; \
                _Pragma("unroll") for (int e = 0; e < 16; ++e) ss += kv[e] * kv[e]; \
                ss += __shfl_xor(ss, 1); ss += __shfl_xor(ss, 2); ss += __shfl_xor(ss, 4); \
                const float rk = rsqrtf(ss * (1.0f / 128.0f) + EPS); \
                _Pragma("unroll") for (int e = 0; e < 16; ++e) kv[e] = kv[e] * rk * kgv[e]; \
                if (kind == 0 && sub == 0) { \
                    float* nk = p.out + (size_t)MTOK * DM + ((size_t)((b * 2 + layer) * 256 + (ci) * 64 + kkey) * 8 + h) * 128 + kd; \
                    _Pragma("unroll") for (int j = 0; j < 4; ++j) *(f32x4*)(nk + 4 * j) = (f32x4){kv[4 * j], kv[4 * j + 1], kv[4 * j + 2], kv[4 * j + 3]}; \
                } \
                w0.x = pk2(kv[0], kv[1]); w0.y = pk2(kv[2], kv[3]); w0.z = pk2(kv[4], kv[5]); w0.w = pk2(kv[6], kv[7]); \
                w1.x = pk2(kv[8], kv[9]); w1.y = pk2(kv[10], kv[11]); w1.z = pk2(kv[12], kv[13]); w1.w = pk2(kv[14], kv[15]); \
            } \
            *(LAS u32x4*)(Ks + kkey * 136 + kd) = w0; *(LAS u32x4*)(Ks + kkey * 136 + kd + 8) = w1; \
            { const unsigned vw[8] = {V0.x, V0.y, V0.z, V0.w, V1.x, V1.y, V1.z, V1.w}; \
              _Pragma("unroll") for (int j = 0; j < 8; ++j) { Vt[(vd + 2 * j) * 72 + vkey] = (bf16)(vw[j] & 0xffffu); Vt[(vd + 2 * j + 1) * 72 + vkey] = (bf16)(vw[j] >> 16); } } \
        } \
        __syncthreads(); \
        AT_LOAD((ci) + 2, K0, K1, V0, V1); \
        const int kr = kr0 + (ci); \
        const bool win = (kind == 1 && !cached); \
        if (!(win && (kr < rs_ || kr >= rs_ + 8))) {     \
        f32x4 st[4]; \
        _Pragma("unroll") for (int kt = 0; kt < 4; ++kt) { st[kt] = (f32x4){0.f, 0.f, 0.f, 0.f}; \
            _Pragma("unroll") for (int ks = 0; ks < 4; ++ks) { const bf16x8 a = *(const LAS bf16x8*)(Ks + (16 * kt + q16) * 136 + 32 * ks + 8 * g); \
                st[kt] = __builtin_amdgcn_mfma_f32_16x16x32_bf16(a, qf[ks], st[kt], 0, 0, 0); } } \
        if (win) { \
            const LAS float* br = rpbL + (kr - r + 7) * 31 + (15 - qc); \
            _Pragma("unroll") for (int kt = 0; kt < 4; ++kt) \
                _Pragma("unroll") for (int e = 0; e < 4; ++e) { const int kc = 16 * kt + 4 * g + e; const bool ok = (kc >= cs) && (kc < cs + 16); \
                    const float bias = ok ? br[kc] : 0.f; st[kt][e] = ok ? st[kt][e] + bias : -1e30f; } \
        } \
        float mx = -1e30f; \
        _Pragma("unroll") for (int kt = 0; kt < 4; ++kt) \
            _Pragma("unroll") for (int e = 0; e < 4; ++e) mx = fmaxf(mx, st[kt][e]); \
        mx = fmaxf(mx, __shfl_xor(mx, 16)); mx = fmaxf(mx, __shfl_xor(mx, 32)); \
        const float m_new = fmaxf(m_run, mx); \
        const float alpha = __builtin_amdgcn_exp2f(m_run - m_new); \
        m_run = m_new; \
        float ps = 0.f; \
        _Pragma("unroll") for (int kt = 0; kt < 4; ++kt) \
            _Pragma("unroll") for (int e = 0; e < 4; ++e) { const float pe = __builtin_amdgcn_exp2f(st[kt][e] - m_new); st[kt][e] = pe; ps += pe; } \
        lsum = lsum * alpha + ps; \
        _Pragma("unroll") for (int dt = 0; dt < 8; ++dt) o[dt] = o[dt] * alpha; \
        bf16x8 pb[2]; \
        _Pragma("unroll") for (int pr = 0; pr < 2; ++pr) { u32x4 w; w.x = pk2(st[2 * pr][0], st[2 * pr][1]); w.y = pk2(st[2 * pr][2], st[2 * pr][3]); w.z = pk2(st[2 * pr + 1][0], st[2 * pr + 1][1]); w.w = pk2(st[2 * pr + 1][2], st[2 * pr + 1][3]); \
            pb[pr] = __builtin_bit_cast(bf16x8, w); } \
        _Pragma("unroll") for (int dt = 0; dt < 8; ++dt) \
            _Pragma("unroll") for (int pr = 0; pr < 2; ++pr) { \
                const LAS bf16* vp = Vt + (16 * dt + q16) * 72 + 32 * pr + 4 * g; \
                const u32x2 lo = *(const LAS u32x2*)vp, hi = *(const LAS u32x2*)(vp + 16); \
                u32x4 w; w.x = lo.x; w.y = lo.y; w.z = hi.x; w.w = hi.y; \
                o[dt] = __builtin_amdgcn_mfma_f32_16x16x32_bf16(__builtin_bit_cast(bf16x8, w), pb[pr], o[dt], 0, 0, 0); \
            } \
        } } while (0)
    AT_LOAD(0, kA0, kA1, vA0, vA1);
    AT_LOAD(1, kB0, kB1, vB0, vB1);
    u32x2 gaw[8];
    { const bf16* gap = P + (size_t)tokq * NIN + OFF_GA + h * 128;
#pragma unroll
      for (int dt = 0; dt < 8; ++dt) gaw[dt] = *(const u32x2*)(gap + 16 * dt + 4 * g); }
    bf16x8 qf[4];
    {
        float qv[4][8]; float ss = 0.f;
#pragma unroll
        for (int ks = 0; ks < 4; ++ks) { const u32x4 w = *(const u32x4*)(P + (size_t)tokq * NIN + OFF_Q + h * 128 + 32 * ks + 8 * g); unpack8(w, qv[ks]);
#pragma unroll
            for (int e = 0; e < 8; ++e) ss += qv[ks][e] * qv[ks][e]; }
        ss += __shfl_xor(ss, 16); ss += __shfl_xor(ss, 32);
        const float rq = rsqrtf(ss * (1.0f / 128.0f) + EPS) * (0.08838834764831845f * 1.4426950408889634f);
#pragma unroll
        for (int ks = 0; ks < 4; ++ks) { float t[8];
#pragma unroll
            for (int e = 0; e < 8; ++e) t[e] = qv[ks][e] * rq * qg[32 * ks + 8 * g + e];
            u32x4 w; w.x = pk2(t[0], t[1]); w.y = pk2(t[2], t[3]); w.z = pk2(t[4], t[5]); w.w = pk2(t[6], t[7]);
            qf[ks] = __builtin_bit_cast(bf16x8, w); }
    }
    __syncthreads();
    if (kind == 1) { for (int i = tid; i < 465; i += NTHR) rpbL[i] = p.in[I_RPB][(size_t)(layer * 8 + h) * 465 + i] * 1.4426950408889634f; }
    float m_run = -1e30f, lsum = 0.f;
    f32x4 o[8];
#pragma unroll
    for (int dt = 0; dt < 8; ++dt) o[dt] = (f32x4){0.f, 0.f, 0.f, 0.f};
#pragma unroll 1
    for (int ci = 0; ci < nchunks; ci += 2) {
        AT_CHUNK(ci, kA0, kA1, vA0, vA1);
        if (ci + 1 < nchunks) AT_CHUNK(ci + 1, kB0, kB1, vB0, vB1);
    }
#undef AT_LOAD
#undef AT_CHUNK
    lsum += __shfl_xor(lsum, 16); lsum += __shfl_xor(lsum, 32);
    const float inv = 1.0f / lsum;
    bf16* yp = Y + (size_t)tokq * DM + h * 128;
#pragma unroll
    for (int dt = 0; dt < 8; ++dt) {
        const int d0 = 16 * dt + 4 * g;
        const u32x2 gw = gaw[dt];
        const float g0 = bf2f(gw.x & 0xffffu), g1 = bf2f(gw.x >> 16), g2 = bf2f(gw.y & 0xffffu), g3 = bf2f(gw.y >> 16);
        u32x2 w; w.x = pk2(o[dt][0] * inv * siluf_(g0), o[dt][1] * inv * siluf_(g1)); w.y = pk2(o[dt][2] * inv * siluf_(g2), o[dt][3] * inv * siluf_(g3));
        *(u32x2*)(yp + d0) = w;
    }
}

template <int L, int NB>
__device__ __forceinline__ void hyena_unit(const Params& p, LAS unsigned char* lds, const int tid, int c, int layer) {
    constexpr int NT = L * NB, PER = NT / NTHR, LAT = (L == 2048);
    LAS float* zb = (LAS float*)lds; LAS float* x1b = zb + NT; LAS float* x2b = x1b + NT; LAS float* tf = x2b + NT;
    const bf16* HT = (const bf16*)(p.ws + WS_HT) + (LAT ? (size_t)32 * 2048 * 256 : 0);
    const bf16* KF = (const bf16*)(p.ws + WS_KF) + (size_t)layer * KF_LAYER + (LAT ? KF_LK0 : 0);
    bf16* Y = (bf16*)(p.ws + WS_YMIX);
    constexpr int Lp = 2 * L + 16;
    const float* cw = p.in[I_CW] + (size_t)layer * 3 * 1536; const float* cb = p.in[I_CB] + layer * 1536;
    __syncthreads();
    for (int j = 0; j < 3; ++j) {
        const float w0 = cw[0 * 1536 + j * 512 + c], w1 = cw[1 * 1536 + j * 512 + c], w2 = cw[2 * 1536 + j * 512 + c], bb = cb[j * 512 + c];
        LAS float* dst = j == 0 ? zb : (j == 1 ? x1b : x2b);
        for (int idx = tid; idx < NT; idx += NTHR) {
            const int bat = idx / L, t = idx % L;
            const bf16* row = HT + ((size_t)bat * 2048 + j * 512 + c) * L;
            const float xm = t > 0 ? bf2f(row[t - 1]) : 0.f, x0 = bf2f(row[t]), xp = t < L - 1 ? bf2f(row[t + 1]) : 0.f;
            dst[idx] = xm * w0 + x0 * w1 + xp * w2 + bb;
        }
    }
    for (int o = 0; o < 2; ++o) {
        __syncthreads();
        const bf16* kf = KF + (size_t)((o * 512 + c) * 8) * Lp;
        for (int x = tid; x < 2 * L; x += NTHR) tf[x] = bf2f(kf[x]);
        __syncthreads();
        const LAS float* zin = o == 0 ? zb : x1b;
        const float hb = p.in[I_HYB][(layer * 2 + o) * 512 + c];
        float acc[PER];
#pragma unroll
        for (int j = 0; j < PER; ++j) acc[j] = 0.f;
        if constexpr (LAT) {
#pragma unroll 2
            for (int s = 0; s < L; ++s) {
                const float z0 = zin[s], z1 = zin[L + s];
#pragma unroll
                for (int j = 0; j < 4; ++j) { const float tp = tf[L - (tid + 512 * j) + s]; acc[j] += tp * z0; acc[4 + j] += tp * z1; }
            }
        } else {
            const int t = tid & 255, b0 = tid >> 8;
#pragma unroll 2
            for (int s = 0; s < L; ++s) {
                const float tp = tf[L - t + s];
#pragma unroll
                for (int j = 0; j < PER; ++j) acc[j] += tp * zin[(b0 + 2 * j) * L + s];
            }
        }
        __syncthreads();
#pragma unroll
        for (int j = 0; j < PER; ++j) {
            int bat, t;
            if constexpr (LAT) { bat = j >> 2; t = tid + 512 * (j & 3); } else { bat = (tid >> 8) + 2 * j; t = tid & 255; }
            const int idx = bat * L + t;
            if (o == 0) { x1b[idx] = x1b[idx] * (acc[j] + hb * zb[idx]); }
            else {
                const float zz = x2b[idx] * (acc[j] + hb * x1b[idx]);
                const float gc = bf2f(HT[((size_t)bat * 2048 + 1536 + c) * L + t]);
                const size_t tok = LAT ? (size_t)(NCTX + bat * 2048 + t) : (size_t)(bat * 256 + t);
                Y[tok * DM + 1536 + c] = (bf16)f2bf(zz * siluf_(gc));
            }
        }
    }
}

#ifndef PROBE
#define PROBE 0
#endif
#define REPM(k) _Pragma("unroll 1") for (int rm_ = 0; rm_ < ((PROBE == (k)) ? 2 : 1); ++rm_)
template <int L, int NB>
__device__ __forceinline__ void hyena_mfma_unit(const Params& p, LAS unsigned char* lds, const int tid, int unit, int layer) {
    constexpr bool LAT = (L == 2048);
    constexpr int NBLK = L / 64, NCOL = NB * NBLK, Lp = 2 * L + 16, MTW = LAT ? 2 : 4;
    constexpr int TC_BYTES = 8 * Lp * 2, Z_OFF = TC_BYTES, Z_BYTES = NCOL * 72 * 2, X1_OFF = Z_OFF + Z_BYTES, X_BYTES = NCOL * 68 * 4, X2_OFF = X1_OFF + X_BYTES;
    constexpr int CH = LAT ? 4 : 2;
    constexpr int OUT_OFF = X2_OFF + X_BYTES, OUT_BYTES = NB * L * CH * 2;
    static_assert(OUT_OFF + OUT_BYTES <= LDS_WORD_OFF, "hyena LDS");
    const int lane = tid & 63, wave = tid >> 6, q = lane & 15, g = lane >> 4;
    LAS bf16* OB = (LAS bf16*)(lds + OUT_OFF);
    LAS bf16* Tc = (LAS bf16*)lds; LAS bf16* Z = (LAS bf16*)(lds + Z_OFF); LAS float* X1 = (LAS float*)(lds + X1_OFF); LAS float* X2 = (LAS float*)(lds + X2_OFF);
    const bf16* HT = (const bf16*)(p.ws + WS_HT) + (LAT ? (size_t)32 * 2048 * 256 : 0);
    const bf16* KF = (const bf16*)(p.ws + WS_KF) + (size_t)layer * KF_LAYER + (LAT ? KF_LK0 : 0);
    bf16* Y = (bf16*)(p.ws + WS_YMIX);
    const float* cw = p.in[I_CW] + (size_t)layer * 3 * 1536; const float* cb = p.in[I_CB] + layer * 1536;
    const int nt = LAT ? (wave & 3) : wave, mt0 = LAT ? 2 * (wave >> 2) : 0;
    const int n = 16 * nt + q, I = n & (NBLK - 1), bat = n / NBLK;
#pragma unroll 1
    for (int cc = 0; cc < CH; ++cc) {
    const int c = unit * CH + cc;
    u32x4 tp0 = (u32x4){0u, 0u, 0u, 0u}, tp1 = (u32x4){0u, 0u, 0u, 0u};
    if (tid < (2 * L) / 8) { tp0 = ((const u32x4*)(KF + (size_t)(0 * 512 + c) * Lp))[tid]; tp1 = ((const u32x4*)(KF + (size_t)(1 * 512 + c) * Lp))[tid]; }
    u32x2 gcw[MTW];
#pragma unroll
    for (int mi = 0; mi < MTW; ++mi) gcw[mi] = *(const u32x2*)(HT + ((size_t)bat * 2048 + 1536 + c) * L + 64 * I + 16 * (mt0 + mi) + 4 * g);
    __syncthreads();
    REPM(20)
#pragma unroll
    for (int it = 0; it < NB * L / 8 / NTHR; ++it) {
        const int idx8 = tid + NTHR * it, bat = idx8 / (L / 8), t0 = (idx8 % (L / 8)) * 8, n = bat * NBLK + (t0 >> 6), i0 = t0 & 63;
#pragma unroll
        for (int j = 0; j < 3; ++j) {
            const bf16* row = HT + ((size_t)bat * 2048 + j * 512 + c) * L;
            const u32x4 w = *(const u32x4*)(row + t0);
            float x[10]; x[0] = t0 > 0 ? bf2f(row[t0 - 1]) : 0.f; unpack8(w, x + 1); x[9] = (t0 + 8 < L) ? bf2f(row[t0 + 8]) : 0.f;
            const float w0 = cw[0 * 1536 + j * 512 + c], w1 = cw[1 * 1536 + j * 512 + c], w2 = cw[2 * 1536 + j * 512 + c], bb = cb[j * 512 + c];
            float y[8];
#pragma unroll
            for (int e = 0; e < 8; ++e) y[e] = x[e] * w0 + x[e + 1] * w1 + x[e + 2] * w2 + bb;
            if (j == 0) { u32x4 o; o.x = pk2(y[0], y[1]); o.y = pk2(y[2], y[3]); o.z = pk2(y[4], y[5]); o.w = pk2(y[6], y[7]); *(LAS u32x4*)(Z + n * 72 + i0) = o; }
            else { LAS float* X = (j == 1 ? X1 : X2) + n * 68 + i0; *(LAS f32x4*)X = (f32x4){y[0], y[1], y[2], y[3]}; *(LAS f32x4*)(X + 4) = (f32x4){y[4], y[5], y[6], y[7]}; }
        }
    }
    const int dlo = LAT ? ((nt & 1) * 16 - 31) : -3, dhi = LAT ? ((nt & 1) * 16 + 15) : 3;
#pragma unroll 1
    for (int o = 0; o < 2; ++o) {
        __syncthreads();
        REPM(21) { __syncthreads();
            if (tid < (2 * L) / 8) ((LAS u32x4*)Tc)[tid] = (o == 0) ? tp0 : tp1;
            __syncthreads();
            const LAS unsigned* D = (const LAS unsigned*)Tc;
            constexpr int NCH = (2 * L) / 8;
            for (int i = tid; i < 7 * NCH; i += NTHR) {
                const int sg = 1 + i / NCH, w0 = (i % NCH) * 4;
                const int a = w0 - ((sg + 1) >> 1);
                unsigned d[5];
#pragma unroll
                for (int k = 0; k < 5; ++k) d[k] = D[max(a + k, 0)];
                u32x4 w;
                if (sg & 1) { w.x = __builtin_amdgcn_alignbit(d[1], d[0], 16); w.y = __builtin_amdgcn_alignbit(d[2], d[1], 16); w.z = __builtin_amdgcn_alignbit(d[3], d[2], 16); w.w = __builtin_amdgcn_alignbit(d[4], d[3], 16); }
                else { w.x = d[0]; w.y = d[1]; w.z = d[2]; w.w = d[3]; }
                *(LAS u32x4*)(Tc + sg * Lp + w0 * 2) = w;
            }
        }
        __syncthreads();
        f32x4 acc[MTW];
#pragma unroll
        for (int mi = 0; mi < MTW; ++mi) acc[mi] = (f32x4){0.f, 0.f, 0.f, 0.f};
        const LAS bf16* tcl = Tc + (q & 7) * Lp + 8 * g + L - (q & 8);
        REPM(22)
#pragma unroll 2
        for (int d = dlo; d <= dhi; ++d) {
            const int J = I - d; const bool valid = (J >= 0) && (J < NBLK);
            const LAS bf16* zp = Z + (valid ? (n - d) : n) * 72 + 8 * g;
#pragma unroll
            for (int jh = 0; jh < 2; ++jh) {
                bf16x8 B = *(const LAS bf16x8*)(zp + 32 * jh);
                if (!valid) B = (bf16x8){0, 0, 0, 0, 0, 0, 0, 0};
#pragma unroll
                for (int mi = 0; mi < MTW; ++mi) {
                    const bf16x8 A = *(const LAS bf16x8*)(tcl + 32 * jh - 16 * (mt0 + mi) - 64 * d);
                    acc[mi] = __builtin_amdgcn_mfma_f32_16x16x32_bf16(A, B, acc[mi], 0, 0, 0);
                }
            }
        }
        __syncthreads();
        const float hb = p.in[I_HYB][(layer * 2 + o) * 512 + c];
#pragma unroll
        for (int mi = 0; mi < MTW; ++mi) {
            const int i = 16 * (mt0 + mi) + 4 * g;
            const u32x2 zw = *(const LAS u32x2*)(Z + n * 72 + i);
            const float z0 = bf2f(zw.x & 0xffffu), z1 = bf2f(zw.x >> 16), z2 = bf2f(zw.y & 0xffffu), z3 = bf2f(zw.y >> 16);
            const f32x4 xv = *(const LAS f32x4*)((o == 0 ? X1 : X2) + n * 68 + i);
            const float r0 = xv.x * (acc[mi][0] + hb * z0), r1 = xv.y * (acc[mi][1] + hb * z1), r2 = xv.z * (acc[mi][2] + hb * z2), r3 = xv.w * (acc[mi][3] + hb * z3);
            if (o == 0) { u32x2 w; w.x = pk2(r0, r1); w.y = pk2(r2, r3); *(LAS u32x2*)(Z + n * 72 + i) = w; }
            else {
                const int t = 64 * I + i;
                const u32x2 gw = gcw[mi];
                LAS bf16* ob = OB + (bat * L + t) * CH + cc;
                ob[0] = (bf16)f2bf(r0 * siluf_(bf2f(gw.x & 0xffffu))); ob[CH] = (bf16)f2bf(r1 * siluf_(bf2f(gw.x >> 16)));
                ob[2 * CH] = (bf16)f2bf(r2 * siluf_(bf2f(gw.y & 0xffffu))); ob[3 * CH] = (bf16)f2bf(r3 * siluf_(bf2f(gw.y >> 16)));
            }
        }
    }
    }
    __syncthreads();
    for (int idx = tid; idx < NB * L; idx += NTHR) {
        const int bt = idx / L, t = idx % L;
        const size_t tok = LAT ? (size_t)(NCTX + bt * 2048 + t) : (size_t)(bt * 256 + t);
        bf16* yp = Y + tok * DM + 1536 + unit * CH;
        if (CH == 4) *(u32x2*)yp = *(const LAS u32x2*)(OB + idx * CH); else if (CH == 2) *(unsigned*)yp = *(const LAS unsigned*)(OB + idx * CH); else *yp = OB[idx];
    }
}

constexpr int Q_FL = 64, Q_HL = 128, Q_AL = 256, Q_HC = 256, Q_AC = 512, Q_FC = 128;
constexpr int Q_TOTAL = Q_FL + Q_HL + Q_AL + Q_HC + Q_AC + Q_FC;
constexpr int PREP_TR = TR_LAYER / 32, PREP_TOTAL = 96 + 128 + PREP_TR + 192;
static_assert(TR_LAYER % 32 == 0, "prep");
__device__ __forceinline__ void phase_mix(const Params& p, LAS unsigned char* lds, int layer, int pass) {
    volatile LAS int* qw = (volatile LAS int*)(lds + LDS_WORD_OFF);
    unsigned* ctr = (unsigned*)(p.ws + WS_CTL) + 64 * (layer * 2 + pass);
    const bf16* P = (const bf16*)(p.ws + WS_P);
    bf16* Y = (bf16*)(p.ws + WS_YMIX);
    unsigned* pctr = (unsigned*)(p.ws + WS_CTL) + 64 * 8;
    bool main_left = true, prep_left = false;
    for (;;) {
        int tid = threadIdx.x; asm volatile("" : "+v"(tid));
        if (prep_left) {
            __syncthreads();
            if (tid == 0) qw[0] = (int)atomicAdd(pctr, 1u);
            __syncthreads();
            const int pid = qw[0];
            if (pid >= PREP_TOTAL) prep_left = false;
            else if (pid < 96) ada_item(p, lds, tid, 96 + pid);
            else if (pid < 224) fold_item(p, lds, tid, 128 + (pid - 96));
            else if (pid < 224 + PREP_TR) { __syncthreads(); const int base = TR_LAYER + 32 * (pid - 224) + 4 * (tid >> 6);
                for (int k = 0; k < 4; ++k) transpose_witem(p, (LAS float*)(lds + (tid >> 6) * 16384), tid & 63, base + k); }
            else taps_any(p, lds, tid, 1, pid - 224 - PREP_TR);
        }
        if (!main_left) { if (!prep_left) break; continue; }
        __syncthreads();
        if (tid == 0) qw[0] = (int)atomicAdd(ctr, 1u);
        __syncthreads();
        int id = qw[0];
        if (id >= Q_TOTAL) { main_left = false; if (!prep_left) break; continue; }
        if (id < Q_FL) {
            pg8::Gemm g{(const pg8::bf16_t*)(p.ws + WS_DFTL), (const pg8::bf16_t*)(p.ws + WS_ZT) + (size_t)32 * 512 * 256, 4096, 1024, 2048};
            pg8::OneUnit S; S.u.pm = id >> 2; S.u.pn = id & 3; S.u.kind = 0;
            EpiF E{P, Y, 1};
            REPM(12) pg8::gemm_phase<EpiF, pg8::OneUnit, false, true>(lds, g, S, E);
            continue;
        }
        id -= Q_FL;
        if (id < Q_HL) { REPM(8) hyena_mfma_unit<2048, 2>(p, lds, tid, id, layer); continue; }
        id -= Q_HL;
        if (id < Q_AL) { REPM(10) attn_unit(p, lds, tid, 1, id >> 7, (id >> 4) & 7, id & 15, layer); continue; }
        id -= Q_AL;
        if (id < Q_HC) { REPM(9) hyena_mfma_unit<256, 32>(p, lds, tid, id, layer); continue; }
        id -= Q_HC;
        if (id < Q_AC) { REPM(11) attn_unit(p, lds, tid, 0, id >> 4, (id >> 1) & 7, id & 1, layer); continue; }
        id -= Q_AC;
        {
            pg8::Gemm g{(const pg8::bf16_t*)(p.ws + WS_DFTC), (const pg8::bf16_t*)(p.ws + WS_ZT), 512, 32 * 512, 256};
            pg8::OneUnit S; S.u.pm = id >> 6; S.u.pn = id & 63; S.u.kind = 0;
            EpiF E{P, Y, 0};
            REPM(12) pg8::gemm_phase<EpiF, pg8::OneUnit, false, true>(lds, g, S, E);
        }
    }
}

#define RLX_AGENT __ATOMIC_RELAXED, __HIP_MEMORY_SCOPE_AGENT
#define XB_TMO      128
#define XB_XCNT(j)  (256  + 64 * (j))
#define XB_XSUB(j)  (1280 + 64 * (j))
#define XB_XGEN(j)  (2304 + 64 * (j))
#define XB_TOP      3328
#define XB_TOPGEN   3392
#define XCD_BAR_WORDS 3456
#define XB_SPIN_CAP (1u << 18)

__device__ __forceinline__ unsigned xb_ld(unsigned* p)              { return __hip_atomic_load(p, __ATOMIC_RELAXED, __HIP_MEMORY_SCOPE_AGENT); }
__device__ __forceinline__ unsigned xb_add(unsigned* p, unsigned v) { return __hip_atomic_fetch_add(p, v, __ATOMIC_RELAXED, __HIP_MEMORY_SCOPE_AGENT); }
__device__ __forceinline__ unsigned xb_xcc_id() { return (unsigned)__builtin_amdgcn_s_getreg((3 << 11) | 20) & 0xFu; }
#define XB_SPIN(cond, bar) do { unsigned _sp = 0; while (cond) { __builtin_amdgcn_s_sleep(1); \
    if ((++_sp & 255u) == 0u) { if (xb_ld(&(bar)[XB_TMO])) break; if (_sp > XB_SPIN_CAP) { atomicAdd(&(bar)[XB_TMO], 1u); break; } } } } while (0)

struct XcdBarrier {
    unsigned* bar; unsigned x;
    volatile LAS unsigned* st;
};

__device__ __forceinline__ XcdBarrier xcd_barrier_post(unsigned* bar, volatile LAS unsigned* st) {
    XcdBarrier b; b.bar = bar; b.x = xb_xcc_id(); b.st = st;
    if (threadIdx.x == 0) (void)xb_add(&bar[XB_XCNT(b.x)], 1u);
    return b;
}
__device__ __forceinline__ void xcd_barrier_complete(unsigned* bar, unsigned x, unsigned& nloc, unsigned& nx) {
    const unsigned G = gridDim.x * gridDim.y * gridDim.z;
    unsigned sum, cnt, mine, sp = 0u;
    for (;;) {
        sum = 0u; cnt = 0u; mine = 0u;
#pragma unroll
        for (unsigned j = 0; j < 16; ++j) { const unsigned c = xb_ld(&bar[XB_XCNT(j)]); sum += c; cnt += (c > 0u) ? 1u : 0u; mine = (j == x) ? c : mine; }
        if (sum == G) break;
        __builtin_amdgcn_s_sleep(1);
        if ((++sp & 255u) == 0u) { if (xb_ld(&bar[XB_TMO])) break; if (sp > XB_SPIN_CAP) { atomicAdd(&bar[XB_TMO], 1u); break; } }
    }
    nloc = mine > 0u ? mine : 1u; nx = cnt > 0u ? cnt : 1u;
}

__device__ __forceinline__ void xcd_barrier(const XcdBarrier& b) {
    asm volatile("s_waitcnt vmcnt(0)" ::: "memory");
    __syncthreads();
    if (threadIdx.x == 0) {
        unsigned* bar = b.bar; asm volatile("" : "+s"(bar));
        __builtin_amdgcn_s_waitcnt(0);
        unsigned nloc = b.st[0], nx = b.st[1];
        if (nloc == 0u) { xcd_barrier_complete(bar, b.x, nloc, nx); b.st[0] = nloc; b.st[1] = nx; }
        const unsigned old = xb_add(&bar[XB_XSUB(b.x)], 1u);
        const unsigned gen = old / nloc;
        if (old + 1u == (gen + 1u) * nloc) {
            __builtin_amdgcn_fence(__ATOMIC_RELEASE, "agent");
            asm volatile("s_waitcnt vmcnt(0)" ::: "memory");
            const unsigned og = xb_add(&bar[XB_TOP], 1u);
            const unsigned tg = og / nx;
            if (og + 1u == (tg + 1u) * nx) xb_add(&bar[XB_TOPGEN], 1u);
            else XB_SPIN(xb_ld(&bar[XB_TOPGEN]) == tg, bar);
            __builtin_amdgcn_fence(__ATOMIC_ACQUIRE, "agent");
            xb_add(&bar[XB_XGEN(b.x)], 1u);
            asm volatile("s_waitcnt vmcnt(0)" ::: "memory");
        } else {
            XB_SPIN(xb_ld(&bar[XB_XGEN(b.x)]) == gen, bar);
            __builtin_amdgcn_fence(__ATOMIC_ACQUIRE, "agent");
            asm volatile("s_waitcnt vmcnt(0)" ::: "memory");
        }
    }
    __syncthreads();
}

__global__ void __launch_bounds__(NTHR, 2) mega_fwd(Params p) {
    extern __shared__ __attribute__((aligned(16))) unsigned char lds_raw[];
    LAS unsigned char* lds = (LAS unsigned char*)lds_raw;
    cg::grid_group grid = cg::this_grid();
    const int G = gridDim.x, bid = blockIdx.x;
#ifndef PROBE
#define PROBE 0
#endif
#define REP(k) _Pragma("unroll 1") for (int rep_ = 0; rep_ < ((PROBE == (k)) ? 2 : 1); ++rep_)
    volatile LAS unsigned* bst = (volatile LAS unsigned*)(lds + LDS_WORD_OFF + 16);
    if (threadIdx.x < 2) bst[threadIdx.x] = 0u;
    __syncthreads();
    const XcdBarrier bar = xcd_barrier_post((unsigned*)(p.ws + WS_CTL) + 1024, bst);
    REP(1) phase0(p, lds);
    if (gridDim.x == 0x7fffffffu) grid.sync();
    xcd_barrier(bar);
#pragma unroll 1
    for (int l = 0; l < 2; ++l) {
        REP(2) { phase_norm(p, l); }
        if (l == 0) { REP(3) phase_taps(p, lds); }
        xcd_barrier(bar);
        REP(4) {
            pg8::Gemm g{(const pg8::bf16_t*)(p.ws + WS_H), (const pg8::bf16_t*)(p.ws + WS_WIN) + (size_t)l * NIN * 2048, MTOK, NIN, 2048};
            pg8::StaticOrder S; S.init(MTOK, NIN, G, bid);
            EpiG1 E{(bf16*)(p.ws + WS_P), (bf16*)(p.ws + WS_ZT), (bf16*)(p.ws + WS_HT), p.out + (size_t)MTOK * DM + (size_t)32 * 2 * 256 * 1024, l};
            pg8::gemm_phase<EpiG1, pg8::StaticOrder, true, true>(lds, g, S, E);
        }
        xcd_barrier(bar);
        REP(5) phase_mix(p, lds, l, rep_);
        xcd_barrier(bar);
        _Pragma("unroll 1") for (int rep_ = 0; rep_ < ((PROBE == 6 && l == 0) ? 2 : 1); ++rep_) {
            pg8::Gemm g{(const pg8::bf16_t*)(p.ws + WS_YMIX), (const pg8::bf16_t*)(p.ws + WS_WBR) + (size_t)l * 2048 * 2048, MTOK, DM, 2048,
                        (const pg8::bf16_t*)(p.ws + WS_H), (const pg8::bf16_t*)(p.ws + WS_WOUT) + (size_t)l * 2048 * 2048};
            Order23 S{G, bid, (unsigned*)(p.ws + WS_CTL) + 8192 + l * 4096};
            EpiG23 E{EpiG2{(const bf16*)(p.ws + WS_P), (bf16*)(p.ws + WS_H)},
                     EpiG3{l == 0 ? p.in[I_XP] : p.out, l == 0 ? p.in[I_XS] : p.out + (size_t)NCTX * DM, p.out, (const float*)(p.ws + WS_ADA) + l * 3 * 6144}};
            pg8::gemm_phase<EpiG23, Order23, true, true>(lds, g, S, E);
        }
        if (l == 0) xcd_barrier(bar);
    }
#if PROBE == 13
    _Pragma("unroll 1") for (int i = 0; i < 20; ++i) grid.sync();
#endif
}

extern "C" void kernel_launch(void* const* d_in, const int* in_sizes, int n_in, void* d_out, int out_size, void* d_ws, size_t ws_size, hipStream_t stream) {
    static int grid = 0;
    if (grid == 0) {
        if (n_in != 24 || ws_size < WS_END) { fprintf(stderr, "kernel_launch: unexpected n_in %d / ws_size %zu\n", n_in, ws_size); grid = -1; return; }
        int dev = 0, cus = 0, per_cu = 0;
        hipGetDevice(&dev);
        hipDeviceGetAttribute(&cus, hipDeviceAttributeMultiprocessorCount, dev);
        hipFuncSetAttribute((const void*)mega_fwd, hipFuncAttributeMaxDynamicSharedMemorySize, LDS_BYTES);
        hipOccupancyMaxActiveBlocksPerMultiprocessor(&per_cu, (const void*)mega_fwd, NTHR, LDS_BYTES);
        (void)hipGetLastError();
        if (per_cu < 1) { fprintf(stderr, "kernel_launch: occupancy query says %d blocks per CU\n", per_cu); per_cu = 1; }
        grid = cus * 1;
    }
    if (grid < 0) return;
    hipMemsetAsync((char*)d_ws + WS_CTL, 0, CTL_BYTES, stream);
    Params p{};
    for (int i = 0; i < 24; ++i) p.in[i] = (const float*)d_in[i];
    p.out = (float*)d_out; p.ws = (unsigned char*)d_ws;
    void* args[] = {&p};
    hipError_t e = hipLaunchCooperativeKernel((const void*)mega_fwd, dim3(grid), dim3(NTHR), args, LDS_BYTES, stream);
    if (e != hipSuccess) fprintf(stderr, "cooperative launch failed: %s (grid %d)\n", hipGetErrorString(e), grid);
}
```
